# Optimizing an MI355X kernel written in HIP

```python
import math
import jax, jax.numpy as jnp
from jax import lax
import numpy as np

D_MODEL = 1024
BATCH = 8
SEQ = 2048
DEPTH = 4

HEAD_DIM = 64
ROPE_THETA = 10000.0
LN_EPS = 1e-5
A_HEADS = 8
IDX_HEADS = 8
IDX_DIM = 32
DSA_TOPK = 256
DSA_Q_BLOCK = 128
B_HEADS = 8
MOBA_BLOCK = 256
MOBA_TOPK = 3
MOBA_Q_CHUNK = 32
C_HEADS = 16
DILATED_CFG = ((128, 1), (512, 4), (2048, 16))
BAND_BLOCK = 128
D_FF = 2816
N_EXPERTS = 8
TOP_K = 2
D_FF_EXPERT = 3584
MOE_BLOCK = 256
DEEPNORM_ALPHA = (2 * DEPTH) ** 0.25
DEEPNORM_BETA = (8 * DEPTH) ** -0.25
N_EVEN = (DEPTH + 1) // 2
N_ODD = DEPTH // 2
EVEN_SPLITS = (A_HEADS * HEAD_DIM, HEAD_DIM, HEAD_DIM, IDX_HEADS * IDX_DIM, IDX_DIM, IDX_HEADS,
               B_HEADS * HEAD_DIM, B_HEADS * HEAD_DIM, B_HEADS * HEAD_DIM)
EVEN_IN = sum(EVEN_SPLITS)
EVEN_MIX = (A_HEADS + B_HEADS) * HEAD_DIM
ODD_MIX = C_HEADS * HEAD_DIM
ODD_IN = 3 * ODD_MIX

kernel_name = 'hybrid_dsa_moba_dilated_deepnorm_moe'

F32 = jnp.float32


def split_cols(h, sizes):
    idx = [int(v) for v in np.cumsum(sizes)[:-1]]
    return jnp.split(h, idx, axis=-1)


def layer_norm(x, g, b):
    xf = x.astype(F32)
    mu = xf.mean(-1, keepdims=True)
    var = jnp.mean(jnp.square(xf - mu), -1, keepdims=True)
    return ((xf - mu) * lax.rsqrt(var + LN_EPS) * g.astype(F32) + b.astype(F32)).astype(x.dtype)


def rope_tables(seq, dim):
    inv = ROPE_THETA ** (-jnp.arange(0, dim, 2, dtype=F32) / dim)
    ang = jnp.arange(seq, dtype=F32)[:, None] * inv[None, :]
    return jnp.cos(ang), jnp.sin(ang)


def apply_rope(x, cos, sin):
    half = x.shape[-1] // 2
    xf = x.astype(F32)
    x1, x2 = xf[..., :half], xf[..., half:]
    c, s = cos[None, :, None, :], sin[None, :, None, :]
    return jnp.concatenate([x1 * c - x2 * s, x1 * s + x2 * c], -1).astype(x.dtype)


def dsa_attention(q, k, v, iq, ik, iw):
    B, S, H, Dh = q.shape
    topk = min(DSA_TOPK, S // 4)
    qb = min(DSA_Q_BLOCK, S)
    nq = S // qb

    def chunk(t):
        return jnp.moveaxis(t.reshape((B, nq, qb) + t.shape[2:]), 1, 0)

    ikf = ik.astype(F32)
    key_pos = jnp.arange(S)
    take = jax.vmap(lambda rows, idx: rows[idx])

    def block(args):
        qc, iqc, iwc, start = args
        qpos = start + jnp.arange(qb)
        rel = jax.nn.relu(jnp.einsum('bqhi,bsi->bqhs', iqc.astype(F32), ikf) * IDX_DIM ** -0.5)
        score = jnp.einsum('bqhs,bqh->bqs', rel, iwc.astype(F32) * IDX_HEADS ** -0.5)
        causal = key_pos[None, :] <= qpos[:, None]
        score = jnp.where(causal[None], score, -jnp.inf)
        _, sel = lax.top_k(score, topk)
        valid = sel <= qpos[None, :, None]
        kg = take(k, sel)
        vg = take(v, sel)
        s = jnp.einsum('bqhd,bqkd->bqhk', qc, kg, preferred_element_type=F32) * Dh ** -0.5
        s = jnp.where(valid[:, :, None, :], s, -jnp.inf)
        p = jax.nn.softmax(s, axis=-1).astype(v.dtype)
        return jnp.einsum('bqhk,bqkd->bqhd', p, vg)

    starts = jnp.arange(nq, dtype=jnp.int32) * qb
    o = lax.map(block, (chunk(q), chunk(iq), chunk(iw), starts))
    return jnp.moveaxis(o, 0, 1).reshape(B, S, H, Dh)


def moba_attention(q, k, v):
    B, S, H, Dh = q.shape
    bs = MOBA_BLOCK
    nb = -(-S // bs)
    Sp = nb * bs
    scale = Dh ** -0.5
    pad = ((0, 0), (0, Sp - S), (0, 0), (0, 0))
    qb = jnp.pad(q, pad).reshape(B, nb, bs, H, Dh)
    kb = jnp.pad(k, pad).reshape(B, nb, bs, H, Dh)
    vb = jnp.pad(v, pad).reshape(B, nb, bs, H, Dh)
    s_own = jnp.einsum('bnqhd,bnkhd->bnhqk', qb, kb, preferred_element_type=F32) * scale
    tri = jnp.tril(jnp.ones((bs, bs), dtype=bool))
    s_own = jnp.where(tri, s_own, -jnp.inf)
    lse_own = jax.nn.logsumexp(s_own, axis=-1)
    p_own = jnp.exp(s_own - lse_own[..., None]).astype(v.dtype)
    o_own = jnp.einsum('bnhqk,bnkhd->bnqhd', p_own, vb).reshape(B, Sp, H, Dh)[:, :S]
    lse_own = jnp.moveaxis(lse_own, 2, 3).reshape(B, Sp, H)[:, :S]
    kt = min(MOBA_TOPK, nb - 1)
    if kt == 0:
        return o_own
    kmean = kb.astype(F32).mean(axis=2)
    gate = jnp.einsum('bshd,bnhd->bshn', q.astype(F32), kmean)
    qblk = jnp.arange(S) // bs
    past = jnp.arange(nb)[None, :] < qblk[:, None]
    gate = jnp.where(past[None, :, None, :], gate, -jnp.inf)
    _, sel = lax.top_k(gate, kt)
    valid = sel < qblk[None, :, None, None]
    kbh = jnp.transpose(kb, (0, 3, 1, 2, 4))
    vbh = jnp.transpose(vb, (0, 3, 1, 2, 4))
    take = jax.vmap(jax.vmap(lambda blocks, idx: blocks[idx]))
    qc_size = min(MOBA_Q_CHUNK, S)
    nc = S // qc_size

    def chunk(t):
        return jnp.moveaxis(t.reshape((B, nc, qc_size) + t.shape[2:]), 1, 0)

    def block(args):
        qc, selc, validc, oc, lc = args
        qh = jnp.swapaxes(qc, 1, 2)
        selh = jnp.swapaxes(selc, 1, 2)
        validh = jnp.swapaxes(validc, 1, 2)
        kg = take(kbh, selh)
        vg = take(vbh, selh)
        s = jnp.einsum('bhcd,bhcjkd->bhcjk', qh, kg, preferred_element_type=F32) * scale
        s = jnp.where(validh[..., None], s, -jnp.inf)
        m = jnp.where(jnp.any(validh, -1), jnp.max(s, axis=(-2, -1)), 0.0)
        e = jnp.exp(s - m[..., None, None])
        den = e.sum(axis=(-2, -1))
        num = jnp.einsum('bhcjk,bhcjkd->bhcd', e.astype(v.dtype), vg, preferred_element_type=F32)
        lo = jnp.swapaxes(lc, 1, 2)
        oo = jnp.swapaxes(oc, 1, 2).astype(F32)
        mx = jnp.maximum(lo, m)
        a = jnp.exp(lo - mx)
        c = jnp.exp(m - mx)
        out = (a[..., None] * oo + c[..., None] * num) / (a + c * den)[..., None]
        return jnp.swapaxes(out, 1, 2).astype(v.dtype)

    o = lax.map(block, (chunk(q), chunk(sel), chunk(valid), chunk(o_own), chunk(lse_own)))
    return jnp.moveaxis(o, 0, 1).reshape(B, S, H, Dh)


def dilated_branch(q, k, v, window, dil):
    B, S, H, Dh = q.shape
    L = S // dil
    wsub = window // dil
    blk = BAND_BLOCK
    nblk = -(-L // blk)
    Lp = nblk * blk

    def strided(t):
        t = t.reshape(B, L, dil, H, Dh).transpose(0, 2, 1, 3, 4)
        t = jnp.pad(t, ((0, 0), (0, 0), (0, Lp - L), (0, 0), (0, 0)))
        return t.reshape(B, dil, nblk, blk, H, Dh)

    def with_prev(t):
        prev = jnp.pad(t, ((0, 0), (0, 0), (1, 0), (0, 0), (0, 0), (0, 0)))[:, :, :-1]
        return jnp.concatenate([prev, t], axis=3)

    qs = strided(q)
    kk = with_prev(strided(k))
    vv = with_prev(strided(v))
    i = jnp.arange(blk)[:, None]
    j = jnp.arange(2 * blk)[None, :]
    dist = blk + i - j
    key_u = jnp.arange(nblk)[:, None, None] * blk - blk + j[None]
    mask = (dist >= 0)[None] & (dist <= wsub)[None] & (key_u >= 0)
    s = jnp.einsum('bgnqhd,bgnkhd->bgnhqk', qs, kk, preferred_element_type=F32) * Dh ** -0.5
    s = jnp.where(mask[None, None, :, None], s, -jnp.inf)
    lse = jax.nn.logsumexp(s, axis=-1)
    p = jnp.exp(s - lse[..., None]).astype(v.dtype)
    o = jnp.einsum('bgnhqk,bgnkhd->bgnqhd', p, vv)
    o = o.reshape(B, dil, Lp, H, Dh)[:, :, :L].transpose(0, 2, 1, 3, 4).reshape(B, S, H, Dh)
    lse = jnp.moveaxis(lse, 3, 4).reshape(B, dil, Lp, H)[:, :, :L].transpose(0, 2, 1, 3).reshape(B, S, H)
    return o, lse


def dilated_mixture(q, k, v):
    outs, lses = [], []
    for window, dil in DILATED_CFG:
        o, l = dilated_branch(q, k, v, window, dil)
        outs.append(o)
        lses.append(l)
    wts = jax.nn.softmax(jnp.stack(lses, 0), axis=0)
    o = jnp.sum(wts[..., None] * jnp.stack(outs, 0).astype(F32), axis=0)
    return o.astype(v.dtype)


def even_mixer(x, w_in, w_out, cos64, sin64, cos32, sin32):
    B, S, _ = x.shape
    qa, ka, va, iq, ik, iw, qb, kb, vb = split_cols(x @ w_in, EVEN_SPLITS)
    qa = apply_rope(qa.reshape(B, S, A_HEADS, HEAD_DIM), cos64, sin64)
    ka = apply_rope(ka.reshape(B, S, 1, HEAD_DIM), cos64, sin64)[:, :, 0]
    iq = apply_rope(iq.reshape(B, S, IDX_HEADS, IDX_DIM), cos32, sin32)
    ik = apply_rope(ik.reshape(B, S, 1, IDX_DIM), cos32, sin32)[:, :, 0]
    shp = (B, S, B_HEADS, HEAD_DIM)
    qb = apply_rope(qb.reshape(shp), cos64, sin64)
    kb = apply_rope(kb.reshape(shp), cos64, sin64)
    o_a = dsa_attention(qa, ka, va, iq, ik, iw)
    o_b = moba_attention(qb, kb, vb.reshape(shp))
    o = jnp.concatenate([o_a.reshape(B, S, -1), o_b.reshape(B, S, -1)], axis=-1)
    return o @ w_out


def odd_mixer(x, w_in, w_out, cos64, sin64):
    B, S, _ = x.shape
    q, k, v = split_cols(x @ w_in, (ODD_MIX, ODD_MIX, ODD_MIX))
    shp = (B, S, C_HEADS, HEAD_DIM)
    q = apply_rope(q.reshape(shp), cos64, sin64)
    k = apply_rope(k.reshape(shp), cos64, sin64)
    o = dilated_mixture(q, k, v.reshape(shp))
    return o.reshape(B, S, ODD_MIX) @ w_out


def swiglu(x, w1, w3, w2):
    return (jax.nn.silu(x @ w1) * (x @ w3)) @ w2


def moe_swiglu(x2d, router, w1, w3, w2):
    n_tok, dm = x2d.shape
    logits = (x2d @ router).astype(F32)
    top_val, top_exp = lax.top_k(logits, TOP_K)
    gates = jax.nn.softmax(top_val, axis=-1)
    n_asg = n_tok * TOP_K
    eid = top_exp.reshape(n_asg)
    tok = jnp.repeat(jnp.arange(n_tok, dtype=jnp.int32), TOP_K)
    gate = gates.reshape(n_asg)
    order = jnp.argsort(eid)
    es, ts, gs = eid[order], tok[order], gate[order]
    counts = jnp.bincount(eid, length=N_EXPERTS)
    starts = jnp.cumsum(counts) - counts
    padded = (counts + MOE_BLOCK - 1) // MOE_BLOCK * MOE_BLOCK
    ends = jnp.cumsum(padded)
    pstarts = ends - padded
    dest = pstarts[es] + jnp.arange(n_asg) - starts[es]
    n_blocks = -(-n_asg // MOE_BLOCK) + N_EXPERTS
    xbuf = jnp.zeros((n_blocks * MOE_BLOCK, dm), x2d.dtype).at[dest].set(x2d[ts])
    block_exp = jnp.clip(jnp.searchsorted(ends, jnp.arange(n_blocks) * MOE_BLOCK, side='right'), 0, N_EXPERTS - 1)

    def expert_block(args):
        xb, e = args
        return (jax.nn.silu(xb @ w1[e]) * (xb @ w3[e])) @ w2[e]

    ybuf = lax.map(expert_block, (xbuf.reshape(n_blocks, MOE_BLOCK, dm), block_exp)).reshape(-1, dm)
    contrib = ybuf[dest] * gs[:, None].astype(x2d.dtype)
    return jnp.zeros_like(x2d).at[ts].add(contrib)


def setup_inputs(seed: int = 0) -> dict:
    key = jax.random.key(seed)
    ks = jax.random.split(key, 20)

    def nrm(k, shape, scale):
        return jax.random.normal(k, shape, F32) * scale

    beta = DEEPNORM_BETA
    hd = HEAD_DIM
    even_col = jnp.concatenate([
        jnp.ones((A_HEADS * hd + hd,), F32), jnp.full((hd,), beta, F32),
        jnp.ones((IDX_HEADS * IDX_DIM + IDX_DIM + IDX_HEADS + 2 * B_HEADS * hd,), F32),
        jnp.full((B_HEADS * hd,), beta, F32)])
    odd_col = jnp.concatenate([jnp.ones((2 * ODD_MIX,), F32), jnp.full((ODD_MIX,), beta, F32)])
    d = D_MODEL
    return {
        'x': nrm(ks[0], (BATCH, SEQ, d), 1.0),
        'even_w_in': nrm(ks[1], (N_EVEN, d, EVEN_IN), d ** -0.5) * even_col,
        'even_w_out': nrm(ks[2], (N_EVEN, EVEN_MIX, d), EVEN_MIX ** -0.5 * beta),
        'even_ln1_g': 1.0 + nrm(ks[3], (N_EVEN, d), 0.02),
        'even_ln1_b': nrm(ks[4], (N_EVEN, d), 0.02),
        'even_w1': nrm(ks[5], (N_EVEN, d, D_FF), d ** -0.5),
        'even_w3': nrm(ks[6], (N_EVEN, d, D_FF), d ** -0.5),
        'even_w2': nrm(ks[7], (N_EVEN, D_FF, d), D_FF ** -0.5 * beta),
        'even_ln2_g': 1.0 + nrm(ks[8], (N_EVEN, d), 0.02),
        'even_ln2_b': nrm(ks[9], (N_EVEN, d), 0.02),
        'odd_w_in': nrm(ks[10], (N_ODD, d, ODD_IN), d ** -0.5) * odd_col,
        'odd_w_out': nrm(ks[11], (N_ODD, ODD_MIX, d), ODD_MIX ** -0.5 * beta),
        'odd_ln1_g': 1.0 + nrm(ks[12], (N_ODD, d), 0.02),
        'odd_ln1_b': nrm(ks[13], (N_ODD, d), 0.02),
        'odd_router': nrm(ks[14], (N_ODD, d, N_EXPERTS), d ** -0.5),
        'odd_w1': nrm(ks[15], (N_ODD, N_EXPERTS, d, D_FF_EXPERT), d ** -0.5),
        'odd_w3': nrm(ks[16], (N_ODD, N_EXPERTS, d, D_FF_EXPERT), d ** -0.5),
        'odd_w2': nrm(ks[17], (N_ODD, N_EXPERTS, D_FF_EXPERT, d), D_FF_EXPERT ** -0.5 * beta),
        'odd_ln2_g': 1.0 + nrm(ks[18], (N_ODD, d), 0.02),
        'odd_ln2_b': nrm(ks[19], (N_ODD, d), 0.02),
    }


def reference(x, even_w_in, even_w_out, even_ln1_g, even_ln1_b, even_w1, even_w3, even_w2,
              even_ln2_g, even_ln2_b, odd_w_in, odd_w_out, odd_ln1_g, odd_ln1_b, odd_router,
              odd_w1, odd_w3, odd_w2, odd_ln2_g, odd_ln2_b):
    B, S, D = x.shape
    cos64, sin64 = rope_tables(S, HEAD_DIM)
    cos32, sin32 = rope_tables(S, IDX_DIM)
    a = DEEPNORM_ALPHA
    for layer in range(DEPTH):
        i = layer // 2
        if layer % 2 == 0:
            mix = even_mixer(x, even_w_in[i], even_w_out[i], cos64, sin64, cos32, sin32)
            x = layer_norm(a * x + mix, even_ln1_g[i], even_ln1_b[i])
            ffn = swiglu(x, even_w1[i], even_w3[i], even_w2[i])
            x = layer_norm(a * x + ffn, even_ln2_g[i], even_ln2_b[i])
        else:
            mix = odd_mixer(x, odd_w_in[i], odd_w_out[i], cos64, sin64)
            x = layer_norm(a * x + mix, odd_ln1_g[i], odd_ln1_b[i])
            ffn = moe_swiglu(x.reshape(B * S, D), odd_router[i], odd_w1[i], odd_w3[i], odd_w2[i]).reshape(B, S, D)
            x = layer_norm(a * x + ffn, odd_ln2_g[i], odd_ln2_b[i])
    return x
```

```cpp
#include <hip/hip_runtime.h>
#include <cstdio>
#include <cstdint>
namespace pg8 {
#define PG8_LAS __attribute__((address_space(3)))
typedef unsigned short bf16_t;
typedef short bf16x8 __attribute__((ext_vector_type(8)));
typedef float f32x4 __attribute__((ext_vector_type(4)));
typedef unsigned u32x4 __attribute__((ext_vector_type(4)));
constexpr int BM = 256, BK = 64, HALF = 128, HTB = HALF * BK * 2  , STAGE_BYTES = 8 * HTB, NXCD = 8, WGM = 8;

__host__ __device__ __forceinline__ int lds_byte(int r, int c) { const int st = (r >> 4) * 2 + (c >> 5), rr = r & 15, cc = c & 31, ob = rr * 64 + cc * 2; return st * 1024 + (ob ^ (((ob >> 9) & 1) << 5)); }
__host__ __device__ __forceinline__ void stage_rc(int b, int& R, int& C) { const int st = b / 1024, sb = b % 1024, swz = sb ^ (((sb >> 9) & 1) << 5); R = (st >> 1) * 16 + swz / 64; C = (st & 1) * 32 + (swz % 64) / 2; }
__host__ __device__ __forceinline__ int perm32(int rho) { const int n = rho >> 4, i = rho & 15; return 8 * (i >> 2) + 4 * n + (i & 3); }

struct Unit { int pm, pn; long boff; };
struct Gemm { const bf16_t* A; const bf16_t* Bt; int M, N, K; };

struct StaticOrder {
    int nM, nN, nwg, G, c;
    __host__ __device__ void init(int M, int N, int G_, int c_) { nM = M / BM; nN = N / BM; nwg = nM * nN; G = G_; c = c_; }
    __host__ __device__ bool next(int i, Unit& u) const {
        const long L = (long)i * G + c; if (L >= nwg) return false;
        int wgid = (int)L; { const int q = nwg / NXCD, r = nwg % NXCD, xcd = wgid % NXCD, off = wgid / NXCD; wgid = (xcd < r ? xcd * (q + 1) : r * (q + 1) + (xcd - r) * q) + off; }
        const int nig = WGM * nN, gid = wgid / nig, fm = gid * WGM, gsz = (nM - fm) < WGM ? (nM - fm) : WGM;
        u.pm = fm + ((wgid % nig) % gsz); u.pn = (wgid % nig) / gsz; u.boff = 0; return true;
    }
    __device__ __forceinline__ void a_ready(const Unit&) const {}
    __device__ __forceinline__ void done(const Unit&) const {}
};

__device__ __forceinline__ unsigned cvt_pk_bf16(float lo, float hi) { unsigned r; asm volatile("v_cvt_pk_bf16_f32 %0, %1, %2" : "=v"(r) : "v"(lo), "v"(hi)); return r; }
struct EpiStoreBf16 {
    static constexpr bool PERM = true, AFTER_DRAIN = false;
    bf16_t* O; int ldc;
    __device__ __forceinline__ void operator()(const f32x4 (&acc)[2][2][4][2], const Unit& u, int wr, int wc, int fr, int fq) const {
        const int row0 = u.pm * BM + wr * 64 + fr, col0 = u.pn * BM + wc * 32 + 8 * fq;
#pragma unroll
        for (int ai = 0; ai < 2; ++ai)
#pragma unroll
            for (int m = 0; m < 4; ++m) { bf16_t* rowp = O + (size_t)(row0 + ai * HALF + m * 16) * ldc + col0;
#pragma unroll
                for (int bj = 0; bj < 2; ++bj) { const f32x4 v0 = acc[ai][bj][m][0], v1 = acc[ai][bj][m][1];
                    u32x4 w; w.x = cvt_pk_bf16(v0[0], v0[1]); w.y = cvt_pk_bf16(v0[2], v0[3]); w.z = cvt_pk_bf16(v1[0], v1[1]); w.w = cvt_pk_bf16(v1[2], v1[3]);
                    *(u32x4*)(rowp + bj * HALF) = w; } }
    }
};
__device__ __forceinline__ float silu_mul(float g, float u) { return g * u * __builtin_amdgcn_rcpf(1.0f + __builtin_amdgcn_exp2f(-1.4426950408889634f * g)); }
struct EpiSwiGLU {
    static constexpr bool PERM = true, AFTER_DRAIN = false;
    bf16_t* H; int ldh;
    __device__ __forceinline__ void operator()(const f32x4 (&acc)[2][2][4][2], const Unit& u, int wr, int wc, int fr, int fq) const {
        const int row0 = u.pm * BM + wr * 64 + fr, col0 = u.pn * HALF + wc * 32 + 8 * fq;
#pragma unroll
        for (int ai = 0; ai < 2; ++ai)
#pragma unroll
            for (int m = 0; m < 4; ++m) { bf16_t* rowp = H + (size_t)(row0 + ai * HALF + m * 16) * ldh + col0;
                const f32x4 g0 = acc[ai][0][m][0], g1 = acc[ai][0][m][1], u0 = acc[ai][1][m][0], u1 = acc[ai][1][m][1];
                u32x4 w; w.x = cvt_pk_bf16(silu_mul(g0[0], u0[0]), silu_mul(g0[1], u0[1])); w.y = cvt_pk_bf16(silu_mul(g0[2], u0[2]), silu_mul(g0[3], u0[3]));
                w.z = cvt_pk_bf16(silu_mul(g1[0], u1[0]), silu_mul(g1[1], u1[1])); w.w = cvt_pk_bf16(silu_mul(g1[2], u1[2]), silu_mul(g1[3], u1[3]));
                *(u32x4*)rowp = w; }
    }
};
struct EpiF32 {
    static constexpr bool PERM = false, AFTER_DRAIN = false;
    float* O; int ldc; const float* R; float alpha;
    __device__ __forceinline__ void operator()(const f32x4 (&acc)[2][2][4][2], const Unit& u, int wr, int wc, int fr, int fq) const {
        const int row0 = u.pm * BM + wr * 64 + fr, col0 = u.pn * BM + wc * 32 + 4 * fq;
#pragma unroll
        for (int ai = 0; ai < 2; ++ai)
#pragma unroll
            for (int m = 0; m < 4; ++m) { const size_t off = (size_t)(row0 + ai * HALF + m * 16) * ldc + col0;
#pragma unroll
                for (int bj = 0; bj < 2; ++bj)
#pragma unroll
                    for (int n = 0; n < 2; ++n) { f32x4 v = acc[ai][bj][m][n]; if (R) v += alpha * *(const f32x4*)(R + off + bj * HALF + n * 16); *(f32x4*)(O + off + bj * HALF + n * 16) = v; } }
    }
};
struct MoeOrder {
    int nN, nunits, G, c; long estride; int pb[9];
    __device__ __forceinline__ void init(const int* pblk, int nN_, long estride_, int G_, int c_) { nN = nN_; G = G_; c = c_; estride = estride_;
#pragma unroll
        for (int e = 0; e < 9; ++e) pb[e] = __builtin_amdgcn_readfirstlane(pblk[e]);
        nunits = pb[8] * nN; }
    __device__ __forceinline__ bool next(int i, Unit& u) const {
        const int L = i * G + c; if (L >= nunits) return false;
        u.pm = L / nN; u.pn = L - u.pm * nN; int e = 0;
#pragma unroll
        for (int k = 1; k < 8; ++k) e += (u.pm >= pb[k]) ? 1 : 0;
        u.boff = (long)e * estride; return true; }
    __device__ __forceinline__ void a_ready(const Unit&) const {}
    __device__ __forceinline__ void done(const Unit&) const {}
};
template <class Epi, class Sched, bool ALIGN_EPI = false, bool SP2 = false>
__device__ __forceinline__ void gemm_phase(PG8_LAS unsigned char* lds, const Gemm g, const Sched& S, const Epi& E) {
    int tid_ = threadIdx.x; asm volatile("" : "+v"(tid_));
    const int tid = tid_, wid = __builtin_amdgcn_readfirstlane(tid >> 6), lane = tid & 63, wr = wid >> 2, wc = wid & 3, fr = lane & 15, fq = lane >> 4;
    const int K = g.K, nt = K / BK;
    unsigned voffA[2], voffB[2];
#pragma unroll
    for (int i = 0; i < 2; ++i) { int R, C; stage_rc(tid * 16 + i * 8192, R, C); const int Rb = Epi::PERM ? ((R & ~31) + perm32(R & 31)) : R;
        voffA[i] = (unsigned)(R * K + C) * 2u; voffB[i] = (unsigned)(Rb * K + C) * 2u; }
    const size_t kstep = (size_t)(BK * 2);
    const size_t hstep = (size_t)HALF * K * 2;
    const size_t tstep = 2 * hstep;
    const unsigned ldsw = (unsigned)wid * 1024u;
    const int aoff = lds_byte(wr * 64 + fr, fq * 8), boff = lds_byte(wc * 32 + fr, fq * 8);
#define PG8_SA(b, h) (((b) * 2 + (h)) * HTB)
#define PG8_SB(b, h) ((4 + (b) * 2 + (h)) * HTB)
#define PG8_STAGE(bufoff, gbase, voff) do { _Pragma("unroll") for (int _i = 0; _i < 2; ++_i) \
        __builtin_amdgcn_global_load_lds((const unsigned*)((const char*)(gbase) + (voff)[_i]), (PG8_LAS unsigned*)(lds + (bufoff) + ldsw + _i * 8192), 16, 0, 0); } while (0)
#define PG8_LDA(dst, b, h) do { _Pragma("unroll") for (int m = 0; m < 4; ++m) _Pragma("unroll") for (int k = 0; k < 2; ++k) dst[m][k] = *(const PG8_LAS bf16x8*)(lds + PG8_SA(b, h) + aoff + m * 2048 + k * 1024); } while (0)
#define PG8_LDB(dst, b, h) do { _Pragma("unroll") for (int n = 0; n < 2; ++n) _Pragma("unroll") for (int k = 0; k < 2; ++k) dst[n][k] = *(const PG8_LAS bf16x8*)(lds + PG8_SB(b, h) + boff + n * 2048 + k * 1024); } while (0)
#define PG8_MMA(ai, bj, At, Bt) do { __builtin_amdgcn_s_setprio(1); _Pragma("unroll") for (int m = 0; m < 4; ++m) _Pragma("unroll") for (int n = 0; n < 2; ++n) _Pragma("unroll") for (int k = 0; k < 2; ++k) \
        acc[ai][bj][m][n] = __builtin_amdgcn_mfma_f32_16x16x32_bf16(Bt[n][k], At[m][k], acc[ai][bj][m][n], 0, 0, 0); __builtin_amdgcn_s_setprio(0); } while (0)
#define PG8_WAIT_V(n) asm volatile("s_waitcnt vmcnt(" #n ")" ::: "memory")
#define PG8_WAIT_L(n) asm volatile("s_waitcnt lgkmcnt(" #n ")" ::: "memory")
#define PG8_BAR __builtin_amdgcn_s_barrier()
#define PG8_SCHED __builtin_amdgcn_sched_barrier(0)
    Unit cur, nxt; int ui = 0;
    if (!S.next(0, cur)) return;
    f32x4 acc[2][2][4][2];
#pragma unroll
    for (int a = 0; a < 2; ++a)
#pragma unroll
        for (int b = 0; b < 2; ++b)
#pragma unroll
            for (int m = 0; m < 4; ++m)
#pragma unroll
                for (int n = 0; n < 2; ++n) acc[a][b][m][n] = (f32x4){0.f, 0.f, 0.f, 0.f};
    bf16x8 At[4][2], B0[2][2], B1[2][2];
    const char* cA = (const char*)g.A + (size_t)cur.pm * tstep; const char* cB = (const char*)g.Bt + cur.boff + (size_t)cur.pn * tstep;
    S.a_ready(cur);
    if constexpr (SP2) {
        PG8_STAGE(PG8_SB(0, 0), cB, voffB); PG8_STAGE(PG8_SB(0, 1), cB + hstep, voffB); PG8_STAGE(PG8_SA(0, 0), cA, voffA); PG8_STAGE(PG8_SA(0, 1), cA + hstep, voffA);
        if (wr == 1) PG8_BAR;
        PG8_WAIT_V(2); PG8_BAR;
        PG8_STAGE(PG8_SB(1, 0), cB + kstep, voffB); PG8_STAGE(PG8_SA(1, 0), cA + kstep, voffA); PG8_STAGE(PG8_SB(1, 1), cB + hstep + kstep, voffB);
        PG8_WAIT_V(6); PG8_BAR;
    } else {
        PG8_STAGE(PG8_SB(0, 0), cB, voffB); PG8_STAGE(PG8_SA(0, 0), cA, voffA); PG8_STAGE(PG8_SB(0, 1), cB + hstep, voffB); PG8_STAGE(PG8_SA(0, 1), cA + hstep, voffA);
        if (wr == 1) PG8_BAR;
        PG8_WAIT_V(4); PG8_BAR;
        PG8_STAGE(PG8_SB(1, 0), cB + kstep, voffB); PG8_STAGE(PG8_SA(1, 0), cA + kstep, voffA); PG8_STAGE(PG8_SB(1, 1), cB + hstep + kstep, voffB);
        PG8_WAIT_V(6); PG8_BAR;
    }
    for (;;) {
        const bool has_next = S.next(ui + 1, nxt);
        const char* nA = has_next ? (const char*)g.A + (size_t)nxt.pm * tstep : cA; const char* nB = has_next ? (const char*)g.Bt + nxt.boff + (size_t)nxt.pn * tstep : cB;
        for (int t = 0; t < nt; t += 2) {
            const bool last = (t == nt - 2);
            const char* a1 = cA + (size_t)(t + 1) * kstep;
            const char* a2 = last ? nA : cA + (size_t)(t + 2) * kstep; const char* b2 = last ? nB : cB + (size_t)(t + 2) * kstep;
            const char* a3 = a2 + kstep; const char* b3 = b2 + kstep;
            if (last && has_next) S.a_ready(nxt);
            if constexpr (SP2) {
            PG8_LDB(B0, 0, 0); PG8_LDB(B1, 0, 1); PG8_SCHED; PG8_LDA(At, 0, 0); PG8_STAGE(PG8_SA(1, 1), a1 + hstep, voffA);
            PG8_WAIT_V(8); PG8_WAIT_L(0); PG8_BAR; PG8_MMA(0, 0, At, B0); PG8_MMA(0, 1, At, B1); PG8_BAR; PG8_SCHED;
            PG8_LDA(At, 0, 1); PG8_STAGE(PG8_SB(0, 0), b2, voffB); PG8_STAGE(PG8_SB(0, 1), b2 + hstep, voffB); PG8_STAGE(PG8_SA(0, 0), a2, voffA);
            PG8_WAIT_V(8); PG8_WAIT_L(0); PG8_BAR; PG8_MMA(1, 0, At, B0); PG8_MMA(1, 1, At, B1); PG8_BAR; PG8_SCHED;
            PG8_LDB(B0, 1, 0); PG8_LDB(B1, 1, 1); PG8_SCHED; PG8_LDA(At, 1, 0); PG8_STAGE(PG8_SA(0, 1), a2 + hstep, voffA);
            PG8_WAIT_V(8); PG8_WAIT_L(0); PG8_BAR; PG8_MMA(0, 0, At, B0); PG8_MMA(0, 1, At, B1); PG8_BAR; PG8_SCHED;
            PG8_LDA(At, 1, 1); PG8_STAGE(PG8_SB(1, 0), b3, voffB); PG8_STAGE(PG8_SB(1, 1), b3 + hstep, voffB); PG8_STAGE(PG8_SA(1, 0), a3, voffA);
            PG8_WAIT_V(8); PG8_WAIT_L(0); PG8_BAR; PG8_MMA(1, 0, At, B0); PG8_MMA(1, 1, At, B1); PG8_BAR; PG8_SCHED;
            } else {
            PG8_LDB(B0, 0, 0); PG8_SCHED; PG8_LDA(At, 0, 0); PG8_STAGE(PG8_SA(1, 1), a1 + hstep, voffA);
            PG8_WAIT_L(8); PG8_BAR; PG8_WAIT_L(0); PG8_MMA(0, 0, At, B0); PG8_BAR; PG8_SCHED;
            PG8_LDB(B1, 0, 1); PG8_STAGE(PG8_SB(0, 0), b2, voffB);
            PG8_BAR; PG8_WAIT_L(0); PG8_MMA(0, 1, At, B1); PG8_BAR;
            PG8_LDA(At, 0, 1); PG8_STAGE(PG8_SA(0, 0), a2, voffA);
            PG8_BAR; PG8_WAIT_L(0); PG8_MMA(1, 0, At, B0); PG8_BAR; PG8_SCHED;
            PG8_STAGE(PG8_SB(0, 1), b2 + hstep, voffB);
            PG8_WAIT_V(6); PG8_BAR; PG8_MMA(1, 1, At, B1); PG8_BAR;
            PG8_LDB(B0, 1, 0); PG8_SCHED; PG8_LDA(At, 1, 0); PG8_STAGE(PG8_SA(0, 1), a2 + hstep, voffA);
            PG8_WAIT_L(8); PG8_BAR; PG8_WAIT_L(0); PG8_MMA(0, 0, At, B0); PG8_BAR; PG8_SCHED;
            PG8_LDB(B1, 1, 1); PG8_STAGE(PG8_SB(1, 0), b3, voffB);
            PG8_BAR; PG8_WAIT_L(0); PG8_MMA(0, 1, At, B1); PG8_BAR;
            PG8_LDA(At, 1, 1); PG8_STAGE(PG8_SA(1, 0), a3, voffA);
            PG8_BAR; PG8_WAIT_L(0); PG8_MMA(1, 0, At, B0); PG8_BAR; PG8_SCHED;
            PG8_STAGE(PG8_SB(1, 1), b3 + hstep, voffB);
            PG8_WAIT_V(6); PG8_BAR; PG8_MMA(1, 1, At, B1); PG8_BAR;
            }
        }
        if constexpr (ALIGN_EPI) { if (wr == 0) PG8_BAR; }
        if constexpr (!Epi::AFTER_DRAIN) { E(acc, cur, wr, wc, fr, fq); S.done(cur); }
        if (!has_next) break;
#pragma unroll
        for (int a = 0; a < 2; ++a)
#pragma unroll
            for (int b = 0; b < 2; ++b)
#pragma unroll
                for (int m = 0; m < 4; ++m)
#pragma unroll
                    for (int n = 0; n < 2; ++n) acc[a][b][m][n] = (f32x4){0.f, 0.f, 0.f, 0.f};
        cur = nxt; cA = nA; cB = nB; ++ui;
        if constexpr (ALIGN_EPI) { if (wr == 1) PG8_BAR; }
    }
    PG8_WAIT_V(0);
    if constexpr (!ALIGN_EPI) { if (wr == 0) PG8_BAR; }
    PG8_BAR;
    if constexpr (Epi::AFTER_DRAIN) { E.fused(acc, cur, wr, wc, fr, fq, lds, wid, lane); S.done(cur); }
#undef PG8_SA
#undef PG8_SB
#undef PG8_STAGE
#undef PG8_LDA
#undef PG8_LDB
#undef PG8_MMA
#undef PG8_WAIT_V
#undef PG8_WAIT_L
#undef PG8_BAR
#undef PG8_SCHED
}
}

#define DI __device__ __forceinline__
#define LAS __attribute__((address_space(3)))
typedef unsigned short bf16;
typedef unsigned u32x4 __attribute__((ext_vector_type(4)));
typedef unsigned u32x2 __attribute__((ext_vector_type(2)));
typedef float f32x4 __attribute__((ext_vector_type(4)));
typedef float f32x2 __attribute__((ext_vector_type(2)));
typedef float f32x16 __attribute__((ext_vector_type(16)));
typedef short bf16x8 __attribute__((ext_vector_type(8)));
typedef short s16x4 __attribute__((ext_vector_type(4)));
typedef unsigned gu32;

constexpr int NB = 8, SEQ = 2048, DM = 1024, NTOK = NB * SEQ;
constexpr int EV_N = 2472, EV_NP = 2560, OD_N = 3072;
constexpr int FF = 2816, FFE = 3584, NEXP = 8;
constexpr int C_QA = 0, C_KA = 512, C_VA = 576, C_IQ = 640, C_IK = 896, C_IW = 928, C_QB = 936, C_KB = 1448, C_VB = 1960;
constexpr int OC_Q = 0, OC_K = 1024, OC_V = 2048;
constexpr float ALPHA = 1.6817928305074290f;
constexpr float LN_EPS = 1e-5f;
constexpr float QSCALE = 0.125f * 1.4426950408889634f;
constexpr int MOE_ROWS = 2 * NTOK + NEXP * 256;
constexpr int NWAVES = 8, NTHR = 512;

constexpr size_t MiB = 1u << 20;
constexpr size_t WS_CTL = 0, CTL_ZERO_BYTES = 1 * MiB;
constexpr size_t WS_TAB = 1 * MiB;
constexpr size_t WS_MISC = 2 * MiB;
constexpr size_t WS_MASK = 6 * MiB;
constexpr size_t WS_WIN = 10 * MiB, WS_WOUT = 18 * MiB, WS_WUP = 20 * MiB, WS_WDN = 132 * MiB;
constexpr size_t WS_XF = 188 * MiB, WS_XB = 252 * MiB;
constexpr size_t WS_R1 = 284 * MiB;
constexpr size_t WS_O = WS_R1 + 96 * MiB;
constexpr size_t WS_MIX = 524 * MiB;
constexpr size_t WS_XBUF = 660 * MiB;
constexpr size_t WS_END = 728 * MiB;
constexpr size_t MS_EID = 0, MS_GATE = 128 * 1024, MS_ROWOF = 256 * 1024, MS_TOKOF = 384 * 1024, MS_KM = 640 * 1024, MS_PBLK = 768 * 1024, MS_LSE3 = 1 * MiB;
constexpr size_t TB_COS64 = 0, TB_SIN64 = 256 * 1024, TB_COS32 = 512 * 1024, TB_SIN32 = 640 * 1024;
constexpr int CW_TMO = 0, CW_BAR = 4096;

constexpr int LDS_BYTES = 152 * 1024;

DI unsigned f2bf(float f) { unsigned u = __builtin_bit_cast(unsigned, f); return (u + 0x7fffu + ((u >> 16) & 1u)) >> 16; }
DI unsigned pk2(float lo, float hi) { return f2bf(lo) | (f2bf(hi) << 16); }
DI float bf2f(unsigned short h) { return __builtin_bit_cast(float, (unsigned)h << 16); }
DI float bflo(unsigned w) { return __builtin_bit_cast(float, w << 16); }
DI float bfhi(unsigned w) { return __builtin_bit_cast(float, w & 0xffff0000u); }
DI float wave_sum(float v) {
#pragma unroll
    for (int o = 1; o < 64; o <<= 1) v += __shfl_xor(v, o);
    return v;
}
#define LDS_WAIT() asm volatile("s_waitcnt lgkmcnt(0)" ::: "memory")
#define XB_TMO      128
#define XB_XCNT(j)  (256  + 64 * (j))
#define XB_XSUB(j)  (1280 + 64 * (j))
#define XB_XGEN(j)  (2304 + 64 * (j))
#define XB_TOP      3328
#define XB_TOPGEN   3392
#define XCD_BAR_WORDS 3456
#define XB_SPIN_CAP (1u << 18)

__device__ __forceinline__ unsigned xb_ld(unsigned* p)              { return __hip_atomic_load(p, __ATOMIC_RELAXED, __HIP_MEMORY_SCOPE_AGENT); }
__device__ __forceinline__ unsigned xb_add(unsigned* p, unsigned v) { return __hip_atomic_fetch_add(p, v, __ATOMIC_RELAXED, __HIP_MEMORY_SCOPE_AGENT); }
__device__ __forceinline__ unsigned xb_xcc_id() { return (unsigned)__builtin_amdgcn_s_getreg((3 << 11) | 20) & 0xFu; }
#define XB_SPIN(cond, bar) do { unsigned _sp = 0; while (cond) { __builtin_amdgcn_s_sleep(1); \
    if ((++_sp & 255u) == 0u) { if (xb_ld(&(bar)[XB_TMO])) break; if (_sp > XB_SPIN_CAP) { atomicAdd(&(bar)[XB_TMO], 1u); break; } } } } while (0)

struct XcdBarrier {
    unsigned* bar; unsigned x;
    volatile LAS unsigned* st;
};

__device__ __forceinline__ XcdBarrier xcd_barrier_post(unsigned* bar, volatile LAS unsigned* st) {
    XcdBarrier b; b.bar = bar; b.x = xb_xcc_id(); b.st = st;
    if (threadIdx.x == 0) (void)xb_add(&bar[XB_XCNT(b.x)], 1u);
    return b;
}
__device__ __forceinline__ void xcd_barrier_complete(unsigned* bar, unsigned x, unsigned& nloc, unsigned& nx) {
    const unsigned G = gridDim.x * gridDim.y * gridDim.z;
    unsigned sum, cnt, mine, sp = 0u;
    for (;;) {
        sum = 0u; cnt = 0u; mine = 0u;
#pragma unroll
        for (unsigned j = 0; j < 16; ++j) { const unsigned c = xb_ld(&bar[XB_XCNT(j)]); sum += c; cnt += (c > 0u) ? 1u : 0u; mine = (j == x) ? c : mine; }
        if (sum == G) break;
        __builtin_amdgcn_s_sleep(1);
        if ((++sp & 255u) == 0u) { if (xb_ld(&bar[XB_TMO])) break; if (sp > XB_SPIN_CAP) { atomicAdd(&bar[XB_TMO], 1u); break; } }
    }
    nloc = mine > 0u ? mine : 1u; nx = cnt > 0u ? cnt : 1u;
}

__device__ __forceinline__ void xcd_barrier(const XcdBarrier& b) {
    asm volatile("s_waitcnt vmcnt(0)" ::: "memory");
    __syncthreads();
    if (threadIdx.x == 0) {
        unsigned* bar = b.bar;
        __builtin_amdgcn_s_waitcnt(0);
        unsigned nloc = b.st[0], nx = b.st[1];
        if (nloc == 0u) { xcd_barrier_complete(bar, b.x, nloc, nx); b.st[0] = nloc; b.st[1] = nx; }
        const unsigned old = xb_add(&bar[XB_XSUB(b.x)], 1u);
        const unsigned gen = old / nloc;
        if (old + 1u == (gen + 1u) * nloc) {
            __builtin_amdgcn_fence(__ATOMIC_RELEASE, "agent");
            asm volatile("s_waitcnt vmcnt(0)" ::: "memory");
            const unsigned og = xb_add(&bar[XB_TOP], 1u);
            const unsigned tg = og / nx;
            if (og + 1u == (tg + 1u) * nx) xb_add(&bar[XB_TOPGEN], 1u);
            else XB_SPIN(xb_ld(&bar[XB_TOPGEN]) == tg, bar);
            __builtin_amdgcn_fence(__ATOMIC_ACQUIRE, "agent");
            xb_add(&bar[XB_XGEN(b.x)], 1u);
            asm volatile("s_waitcnt vmcnt(0)" ::: "memory");
        } else {
            XB_SPIN(xb_ld(&bar[XB_XGEN(b.x)]) == gen, bar);
            __builtin_amdgcn_fence(__ATOMIC_ACQUIRE, "agent");
            asm volatile("s_waitcnt vmcnt(0)" ::: "memory");
        }
    }
    __syncthreads();
}

DI void tr_item(const float* W, int ldw, int nvalid, int k0, int n0, bf16* WT, int K, int drow0, LAS float* scr, int lane) {
    const int nn = n0 + (lane & 31); const bool ok = nn < nvalid;
#pragma unroll 8
    for (int i = 0; i < 32; ++i) { const int kk = 2 * i + (lane >> 5); scr[kk * 33 + (lane & 31)] = ok ? W[(size_t)(k0 + kk) * ldw + nn] : 0.f; }
    LDS_WAIT(); asm volatile("" ::: "memory");
    const int c = lane & 7;
#pragma unroll
    for (int j = 0; j < 4; ++j) { const int n = (lane >> 3) + 8 * j; const LAS float* s = scr + (8 * c) * 33 + n;
        u32x4 o; o.x = pk2(s[0 * 33], s[1 * 33]); o.y = pk2(s[2 * 33], s[3 * 33]); o.z = pk2(s[4 * 33], s[5 * 33]); o.w = pk2(s[6 * 33], s[7 * 33]);
        *(u32x4*)(WT + (size_t)(drow0 + n) * K + k0 + 8 * c) = o; }
    LDS_WAIT(); asm volatile("" ::: "memory");
}
DI void tr_plain(const float* W, int K, int N, int Npad, bf16* WT, LAS float* scr, int r, int lane) {
    const int nblk = Npad / 32, kb = r / nblk, nb = r % nblk;
    tr_item(W, N, N, 64 * kb, 32 * nb, WT, K, 32 * nb, scr, lane);
}
DI void tr_gu(const float* W, int K, int N, int half, bf16* WT, LAS float* scr, int r, int lane) {
    const int nblk = N / 32, kb = r / nblk, nb = r % nblk, n0 = 32 * nb;
    tr_item(W, N, N, 64 * kb, n0, WT, K, (n0 >> 7) * 256 + (n0 & 127) + half * 128, scr, lane);
}
struct Ptrs {
    const float* in[20]; float* out; unsigned char* ws;
    int tid, lane, wave, bid, G;
};
DI void phase_convert_even(const Ptrs& P, LAS unsigned char* lds, int li) {
    LAS float* scr = (LAS float*)(lds + P.wave * 16384);
    const int gw = P.bid * NWAVES + P.wave, NGW = P.G * NWAVES;
    const float* w_in = P.in[1] + (size_t)li * DM * EV_N; const float* w_out = P.in[2] + (size_t)li * DM * DM;
    const float* w1 = P.in[5] + (size_t)li * DM * FF; const float* w3 = P.in[6] + (size_t)li * DM * FF; const float* w2 = P.in[7] + (size_t)li * FF * DM;
    bf16* WIN = (bf16*)(P.ws + WS_WIN); bf16* WOUT = (bf16*)(P.ws + WS_WOUT); bf16* WUP = (bf16*)(P.ws + WS_WUP); bf16* WDN = (bf16*)(P.ws + WS_WDN);
    constexpr int I_IN = (DM / 64) * (EV_NP / 32), I_OUT = (DM / 64) * (DM / 32), I_GU = (DM / 64) * (FF / 32), I_DN = (FF / 64) * (DM / 32);
    constexpr int NIT = I_IN + I_OUT + 2 * I_GU + I_DN;
    for (int it = gw; it < NIT; it += NGW) {
        int r = it;
        if (r < I_IN) { tr_plain(w_in, DM, EV_N, EV_NP, WIN, scr, r, P.lane); continue; } r -= I_IN;
        if (r < I_OUT) { tr_plain(w_out, DM, DM, DM, WOUT, scr, r, P.lane); continue; } r -= I_OUT;
        if (r < I_GU) { tr_gu(w1, DM, FF, 0, WUP, scr, r, P.lane); continue; } r -= I_GU;
        if (r < I_GU) { tr_gu(w3, DM, FF, 1, WUP, scr, r, P.lane); continue; } r -= I_GU;
        tr_plain(w2, FF, DM, DM, WDN, scr, r, P.lane);
    }
}
DI void phase_convert_odd(const Ptrs& P, LAS unsigned char* lds, int li) {
    LAS float* scr = (LAS float*)(lds + P.wave * 16384);
    const int gw = P.bid * NWAVES + P.wave, NGW = P.G * NWAVES;
    const float* w_in = P.in[10] + (size_t)li * DM * OD_N; const float* w_out = P.in[11] + (size_t)li * DM * DM;
    const float* w1 = P.in[15] + (size_t)li * NEXP * DM * FFE; const float* w3 = P.in[16] + (size_t)li * NEXP * DM * FFE; const float* w2 = P.in[17] + (size_t)li * NEXP * FFE * DM;
    bf16* WIN = (bf16*)(P.ws + WS_WIN); bf16* WOUT = (bf16*)(P.ws + WS_WOUT); bf16* WUP = (bf16*)(P.ws + WS_WUP); bf16* WDN = (bf16*)(P.ws + WS_WDN);
    constexpr int I_IN = (DM / 64) * (OD_N / 32), I_OUT = (DM / 64) * (DM / 32), I_GU = (DM / 64) * (FFE / 32), I_DN = (FFE / 64) * (DM / 32);
    constexpr int NIT = I_IN + I_OUT + NEXP * (2 * I_GU + I_DN);
    for (int it = gw; it < NIT; it += NGW) {
        int r = it;
        if (r < I_IN) { tr_plain(w_in, DM, OD_N, OD_N, WIN, scr, r, P.lane); continue; } r -= I_IN;
        if (r < I_OUT) { tr_plain(w_out, DM, DM, DM, WOUT, scr, r, P.lane); continue; } r -= I_OUT;
        const int e = r / (2 * I_GU + I_DN); r -= e * (2 * I_GU + I_DN);
        if (r < I_GU) { tr_gu(w1 + (size_t)e * DM * FFE, DM, FFE, 0, WUP + (size_t)e * 2 * FFE * DM, scr, r, P.lane); continue; } r -= I_GU;
        if (r < I_GU) { tr_gu(w3 + (size_t)e * DM * FFE, DM, FFE, 1, WUP + (size_t)e * 2 * FFE * DM, scr, r, P.lane); continue; } r -= I_GU;
        tr_plain(w2 + (size_t)e * FFE * DM, FFE, DM, DM, WDN + (size_t)e * DM * FFE, scr, r, P.lane);
    }
}
DI void phase_init(const Ptrs& P) {
    const int gw = P.bid * NWAVES + P.wave, NGW = P.G * NWAVES;
    const float* x = P.in[0]; bf16* XB = (bf16*)(P.ws + WS_XB);
    for (int m = gw; m < NTOK; m += NGW) {
        const f32x4* xr = (const f32x4*)(x + (size_t)m * DM) + P.lane; u32x2* o = (u32x2*)(XB + (size_t)m * DM) + P.lane;
#pragma unroll
        for (int j = 0; j < 4; ++j) { const f32x4 v = xr[64 * j]; u32x2 w; w.x = pk2(v.x, v.y); w.y = pk2(v.z, v.w); o[64 * j] = w; }
    }
    float* c64 = (float*)(P.ws + WS_TAB + TB_COS64); float* s64 = (float*)(P.ws + WS_TAB + TB_SIN64);
    float* c32 = (float*)(P.ws + WS_TAB + TB_COS32); float* s32 = (float*)(P.ws + WS_TAB + TB_SIN32);
    const int gt = P.bid * NTHR + P.tid, NGT = P.G * NTHR;
    for (int i = gt; i < SEQ * 32; i += NGT) { const int pos = i >> 5, j = i & 31; const float inv = exp2f(-(float)j * (13.287712379549449f / 32.0f)); const float a = (float)pos * inv; const double rv = (double)a * 0.15915494309189535; const float fr = (float)(rv - floor(rv)); c64[i] = __builtin_amdgcn_cosf(fr); s64[i] = __builtin_amdgcn_sinf(fr); }
    for (int i = gt; i < SEQ * 16; i += NGT) { const int pos = i >> 4, j = i & 15; const float inv = exp2f(-(float)j * (13.287712379549449f / 16.0f)); const float a = (float)pos * inv; const double rv = (double)a * 0.15915494309189535; const float fr = (float)(rv - floor(rv)); c32[i] = __builtin_amdgcn_cosf(fr); s32[i] = __builtin_amdgcn_sinf(fr); }
}

DI void rope_item(bf16* p, int half, float scale, const float* ct, const float* st) {
    const u32x2 a = *(const u32x2*)p, b = *(const u32x2*)(p + half);
    const f32x4 c = *(const f32x4*)ct, s = *(const f32x4*)st;
    const f32x4 x1 = {bflo(a.x), bfhi(a.x), bflo(a.y), bfhi(a.y)}, x2 = {bflo(b.x), bfhi(b.x), bflo(b.y), bfhi(b.y)};
    const f32x4 o1 = (x1 * c - x2 * s) * scale, o2 = (x1 * s + x2 * c) * scale;
    u32x2 wa, wb; wa.x = pk2(o1.x, o1.y); wa.y = pk2(o1.z, o1.w); wb.x = pk2(o2.x, o2.y); wb.y = pk2(o2.z, o2.w);
    *(u32x2*)p = wa; *(u32x2*)(p + half) = wb;
}
DI void phase_rope_even(const Ptrs& P) {
    const int gw = P.bid * NWAVES + P.wave, NGW = P.G * NWAVES;
    bf16* PROJ = (bf16*)(P.ws + WS_R1);
    const float* c64 = (const float*)(P.ws + WS_TAB + TB_COS64); const float* s64 = (const float*)(P.ws + WS_TAB + TB_SIN64);
    const float* c32 = (const float*)(P.ws + WS_TAB + TB_COS32); const float* s32 = (const float*)(P.ws + WS_TAB + TB_SIN32);
    for (int m = gw; m < NTOK; m += NGW) {
        const int pos = m & (SEQ - 1); bf16* row = PROJ + (size_t)m * EV_NP;
        for (int id = P.lane; id < 236; id += 64) {
            int col, jj, half = 32; float sc = 1.f;
            if (id < 64) { col = C_QA + (id >> 3) * 64; jj = (id & 7) * 4; sc = QSCALE; }
            else if (id < 72) { col = C_KA; jj = (id - 64) * 4; }
            else if (id < 104) { const int k = id - 72; col = C_IQ + (k >> 2) * 32; jj = (k & 3) * 4; half = 16; }
            else if (id < 108) { col = C_IK; jj = (id - 104) * 4; half = 16; }
            else if (id < 172) { const int k = id - 108; col = C_QB + (k >> 3) * 64; jj = (k & 7) * 4; sc = QSCALE; }
            else { const int k = id - 172; col = C_KB + (k >> 3) * 64; jj = (k & 7) * 4; }
            const float* ct = (half == 32) ? c64 + pos * 32 + jj : c32 + pos * 16 + jj;
            const float* st = (half == 32) ? s64 + pos * 32 + jj : s32 + pos * 16 + jj;
            rope_item(row + col + jj, half, sc, ct, st);
        }
    }
}
DI void phase_rope_odd(const Ptrs& P) {
    const int gw = P.bid * NWAVES + P.wave, NGW = P.G * NWAVES;
    bf16* PROJ = (bf16*)(P.ws + WS_R1);
    const float* c64 = (const float*)(P.ws + WS_TAB + TB_COS64); const float* s64 = (const float*)(P.ws + WS_TAB + TB_SIN64);
    for (int m = gw; m < NTOK; m += NGW) {
        const int pos = m & (SEQ - 1); bf16* row = PROJ + (size_t)m * OD_N;
#pragma unroll
        for (int r = 0; r < 4; ++r) { const int id = P.lane + 64 * r;
            const int k = id & 127, col = (id < 128 ? OC_Q : OC_K) + (k >> 3) * 64, jj = (k & 7) * 4;
            rope_item(row + col + jj, 32, id < 128 ? QSCALE : 1.f, c64 + pos * 32 + jj, s64 + pos * 32 + jj); }
    }
}

DI void ln_core(f32x4 (&v)[4], const float* g, const float* b, int lane) {
    float s = 0.f;
#pragma unroll
    for (int j = 0; j < 4; ++j) s += (v[j].x + v[j].y) + (v[j].z + v[j].w);
    const float mean = wave_sum(s) * (1.f / DM); float s2 = 0.f;
#pragma unroll
    for (int j = 0; j < 4; ++j) { v[j] = v[j] - mean; s2 += (v[j].x * v[j].x + v[j].y * v[j].y) + (v[j].z * v[j].z + v[j].w * v[j].w); }
    const float rstd = 1.f / sqrtf(wave_sum(s2) * (1.f / DM) + LN_EPS);
#pragma unroll
    for (int j = 0; j < 4; ++j) { const f32x4 gg = ((const f32x4*)g)[64 * j + lane], bb = ((const f32x4*)b)[64 * j + lane]; v[j] = v[j] * rstd * gg + bb; }
}
DI void ln_store(const f32x4 (&v)[4], float* xf, bf16* xb, int lane) {
#pragma unroll
    for (int j = 0; j < 4; ++j) { ((f32x4*)xf)[64 * j + lane] = v[j]; if (xb) { u32x2 w; w.x = pk2(v[j].x, v[j].y); w.y = pk2(v[j].z, v[j].w); ((u32x2*)xb)[64 * j + lane] = w; } }
}
template <bool ROUTER> DI void phase_ln(const Ptrs& P, LAS unsigned char* lds, const float* g, const float* b, float* xf_out, bf16* xb_out, const float* router) {
    const int gw = P.bid * NWAVES + P.wave, NGW = P.G * NWAVES;
    const float* MIX = (const float*)(P.ws + WS_MIX);
    LAS float* rl = (LAS float*)lds;
    if (ROUTER) { for (int i = P.tid; i < DM * NEXP / 4; i += NTHR) ((LAS f32x4*)rl)[i] = ((const f32x4*)router)[i]; __syncthreads(); }
    int* eid = (int*)(P.ws + WS_MISC + MS_EID); float* gate = (float*)(P.ws + WS_MISC + MS_GATE);
    for (int m = gw; m < NTOK; m += NGW) {
        f32x4 v[4];
#pragma unroll
        for (int j = 0; j < 4; ++j) v[j] = ((const f32x4*)(MIX + (size_t)m * DM))[64 * j + P.lane];
        ln_core(v, g, b, P.lane);
        ln_store(v, xf_out + (size_t)m * DM, xb_out ? xb_out + (size_t)m * DM : nullptr, P.lane);
        if (ROUTER) {
            float lg[8];
#pragma unroll
            for (int e = 0; e < 8; ++e) lg[e] = 0.f;
#pragma unroll
            for (int j = 0; j < 4; ++j)
#pragma unroll
                for (int c = 0; c < 4; ++c) { const int col = 4 * (64 * j + P.lane) + c; const f32x4 r0 = *(const LAS f32x4*)(rl + col * 8), r1 = *(const LAS f32x4*)(rl + col * 8 + 4); const float x = v[j][c];
                    lg[0] += x * r0.x; lg[1] += x * r0.y; lg[2] += x * r0.z; lg[3] += x * r0.w; lg[4] += x * r1.x; lg[5] += x * r1.y; lg[6] += x * r1.z; lg[7] += x * r1.w; }
#pragma unroll
            for (int e = 0; e < 8; ++e) lg[e] = wave_sum(lg[e]);
            int i1 = 0; float v1 = lg[0];
#pragma unroll
            for (int e = 1; e < 8; ++e) if (lg[e] > v1) { v1 = lg[e]; i1 = e; }
            int i2 = -1; float v2 = -INFINITY;
#pragma unroll
            for (int e = 0; e < 8; ++e) if (e != i1 && lg[e] > v2) { v2 = lg[e]; i2 = e; }
            const float ex = expf(v2 - v1), g1 = 1.f / (1.f + ex), g2 = ex / (1.f + ex);
            if (P.lane == 0) { eid[2 * m] = i1; eid[2 * m + 1] = i2; gate[2 * m] = g1; gate[2 * m + 1] = g2; }
        }
    }
}

DI void phase_route(const Ptrs& P, LAS unsigned char* lds) {
    const int* eid = (const int*)(P.ws + WS_MISC + MS_EID);
    int* rowof = (int*)(P.ws + WS_MISC + MS_ROWOF); int* pblk = (int*)(P.ws + WS_MISC + MS_PBLK);
    const bf16* XB = (const bf16*)(P.ws + WS_XB); bf16* XBUF = (bf16*)(P.ws + WS_XBUF);
    LAS int* cl = (LAS int*)lds;
    for (int c = P.bid; c < NTOK / 64; c += P.G) {
        __syncthreads();
        if (P.tid < 32) cl[P.tid] = 0;
        __syncthreads();
        int tot[8], bef[8];
#pragma unroll
        for (int e = 0; e < 8; ++e) { tot[e] = 0; bef[e] = 0; }
        const int a0 = 128 * c;
        for (int k = 0; k < 64; ++k) { const int a = P.tid + NTHR * k; const int e = eid[a]; const int pre = (a < a0) ? 1 : 0;
#pragma unroll
            for (int x = 0; x < 8; ++x) { const int hit = (e == x) ? 1 : 0; tot[x] += hit; bef[x] += hit & pre; } }
#pragma unroll
        for (int x = 0; x < 8; ++x) {
            int t = tot[x], q = bef[x];
#pragma unroll
            for (int o = 1; o < 64; o <<= 1) { t += __shfl_xor(t, o); q += __shfl_xor(q, o); }
            if (P.lane == 0) { __hip_atomic_fetch_add(&cl[x], t, __ATOMIC_RELAXED, __HIP_MEMORY_SCOPE_WORKGROUP); __hip_atomic_fetch_add(&cl[8 + x], q, __ATOMIC_RELAXED, __HIP_MEMORY_SCOPE_WORKGROUP); }
        }
        __syncthreads();
        if (P.tid == 0) { int acc = 0; for (int e = 0; e < 8; ++e) { cl[16 + e] = acc; acc += (cl[e] + 255) >> 8; } cl[24] = acc; }
        __syncthreads();
        if (P.wave == 0) {
            int run[8];
#pragma unroll
            for (int x = 0; x < 8; ++x) run[x] = 0;
            const unsigned long long lt = (P.lane == 0) ? 0ull : (~0ull >> (64 - P.lane));
#pragma unroll
            for (int h = 0; h < 2; ++h) { const int i = 64 * h + P.lane; const int e = eid[a0 + i]; int dest = 0;
#pragma unroll
                for (int x = 0; x < 8; ++x) { const unsigned long long mk = __ballot(e == x); if (e == x) dest = 256 * cl[16 + x] + cl[8 + x] + run[x] + __builtin_popcountll(mk & lt); run[x] += __builtin_popcountll(mk); }
                cl[32 + i] = dest; rowof[a0 + i] = dest; }
        }
        if (c == 0 && P.tid < 9) pblk[P.tid] = cl[16 + P.tid];
        __syncthreads();
        for (int i = P.wave; i < 128; i += NWAVES) { const int dest = cl[32 + i]; const int t = (a0 + i) >> 1;
            const u32x4* s = (const u32x4*)(XB + (size_t)t * DM) + 2 * P.lane; u32x4* d = (u32x4*)(XBUF + (size_t)dest * DM) + 2 * P.lane;
            const u32x4 v0 = s[0], v1 = s[1]; d[0] = v0; d[1] = v1; }
    }
}
DI void phase_moe_combine(const Ptrs& P, const float* g, const float* b, float* xf_out, bf16* xb_out) {
    const int gw = P.bid * NWAVES + P.wave, NGW = P.G * NWAVES;
    const float* XF = (const float*)(P.ws + WS_XF); const float* Y = (const float*)(P.ws + WS_MIX);
    const int* rowof = (const int*)(P.ws + WS_MISC + MS_ROWOF); const float* gate = (const float*)(P.ws + WS_MISC + MS_GATE);
    for (int m = gw; m < NTOK; m += NGW) {
        const int r0 = rowof[2 * m], r1 = rowof[2 * m + 1]; const float g0 = gate[2 * m], g1 = gate[2 * m + 1];
        f32x4 v[4];
#pragma unroll
        for (int j = 0; j < 4; ++j) { const f32x4 x = ((const f32x4*)(XF + (size_t)m * DM))[64 * j + P.lane], y0 = ((const f32x4*)(Y + (size_t)r0 * DM))[64 * j + P.lane], y1 = ((const f32x4*)(Y + (size_t)r1 * DM))[64 * j + P.lane];
            v[j] = ALPHA * x + (g0 * y0 + g1 * y1); }
        ln_core(v, g, b, P.lane);
        ln_store(v, xf_out + (size_t)m * DM, xb_out ? xb_out + (size_t)m * DM : nullptr, P.lane);
    }
}

constexpr int SC_LD = 2052;
DI unsigned fkey(float f) { const unsigned u = __builtin_bit_cast(unsigned, f); return (u & 0x80000000u) ? ~u : (u | 0x80000000u); }
DI void idx_unit(const Ptrs& P, LAS unsigned char* lds, int b, int qb16) {
    const bf16* PROJ = (const bf16*)(P.ws + WS_R1); unsigned* MASK = (unsigned*)(P.ws + WS_MASK);
    LAS float* sc = (LAS float*)lds;
    const int t0 = 16 * qb16, lane = P.lane, l15 = lane & 15, l4 = lane >> 4; const size_t rowbase = (size_t)b * SEQ;
    __syncthreads();
    {
        const bf16* qrow = PROJ + (rowbase + t0 + l15) * EV_NP;
        bf16x8 bq[8];
#pragma unroll
        for (int h = 0; h < 8; ++h) bq[h] = *(const bf16x8*)(qrow + C_IQ + h * 32 + 8 * l4);
        const u32x4 wraw = *(const u32x4*)(qrow + C_IW); float wv[8];
        const float WS = 0.17677669529663687f * 0.35355339059327373f;
        wv[0] = bflo(wraw.x) * WS; wv[1] = bfhi(wraw.x) * WS; wv[2] = bflo(wraw.y) * WS; wv[3] = bfhi(wraw.y) * WS; wv[4] = bflo(wraw.z) * WS; wv[5] = bfhi(wraw.z) * WS; wv[6] = bflo(wraw.w) * WS; wv[7] = bfhi(wraw.w) * WS;
        const int nkt = qb16 + 1;
        for (int kt = P.wave; kt < nkt; kt += NWAVES) {
            const bf16x8 ak = *(const bf16x8*)(PROJ + (rowbase + 16 * kt + l15) * EV_NP + C_IK + 8 * l4);
            f32x4 s = {0.f, 0.f, 0.f, 0.f};
#pragma unroll
            for (int h = 0; h < 8; ++h) { const f32x4 z = {0.f, 0.f, 0.f, 0.f}; const f32x4 d = __builtin_amdgcn_mfma_f32_16x16x32_bf16(ak, bq[h], z, 0, 0, 0);
                s.x += wv[h] * fmaxf(d.x, 0.f); s.y += wv[h] * fmaxf(d.y, 0.f); s.z += wv[h] * fmaxf(d.z, 0.f); s.w += wv[h] * fmaxf(d.w, 0.f); }
            if (kt == nkt - 1) { const int kq = 4 * l4; if (kq + 0 > l15) s.x = -INFINITY; if (kq + 1 > l15) s.y = -INFINITY; if (kq + 2 > l15) s.z = -INFINITY; if (kq + 3 > l15) s.w = -INFINITY; }
            *(LAS f32x4*)(sc + l15 * SC_LD + 16 * kt + 4 * l4) = s;
        }
    }
    __syncthreads();
    const unsigned long long ltm = (lane == 0) ? 0ull : (~0ull >> (64 - lane));
    for (int rr = 0; rr < 2; ++rr) {
        const int r = 2 * P.wave + rr, t = t0 + r; const int jmax = (t >> 6) + 1;
        unsigned key[32];
#pragma unroll
        for (int j = 0; j < 32; ++j) { const int idx = 64 * j + lane; key[j] = 0u; if (j < jmax) { const float f = sc[r * SC_LD + idx]; key[j] = (idx <= t) ? fkey(f) : 0u; } }
        unsigned T = 0u; int need = 0;
        const bool all = (t + 1 <= 256);
        if (!all) {
            for (int bit = 31; bit >= 0; --bit) { const unsigned cand = T | (1u << bit); int cnt = 0;
#pragma unroll
                for (int j = 0; j < 32; ++j) if (j < jmax) cnt += __builtin_popcountll(__ballot(key[j] >= cand));
                if (cnt >= 256) T = cand; }
            int ngt = 0;
#pragma unroll
            for (int j = 0; j < 32; ++j) if (j < jmax) ngt += __builtin_popcountll(__ballot(key[j] > T));
            need = 256 - ngt;
        }
        unsigned myw = 0u; int run = 0;
#pragma unroll
        for (int j = 0; j < 32; ++j) {
            unsigned long long sm = 0ull;
            if (j < jmax) {
                if (all) sm = __ballot(key[j] != 0u);
                else { const bool eq = key[j] == T; const unsigned long long em = __ballot(eq); const int rank = run + __builtin_popcountll(em & ltm);
                       sm = __ballot(key[j] > T || (eq && rank < need)); run += __builtin_popcountll(em); }
            }
            if (lane == 2 * j) myw = (unsigned)sm;
            if (lane == 2 * j + 1) myw = (unsigned)(sm >> 32);
        }
        MASK[(rowbase + t) * 64 + lane] = myw;
    }
}
DI void kmean_unit(const Ptrs& P, int b, int n) {
    const bf16* PROJ = (const bf16*)(P.ws + WS_R1); bf16* KM = (bf16*)(P.ws + WS_MISC + MS_KM);
    const int col = P.tid; const bf16* p = PROJ + ((size_t)b * SEQ + 256 * n) * EV_NP + C_KB + col; float s = 0.f;
#pragma unroll 8
    for (int r = 0; r < 256; ++r) s += bf2f(p[(size_t)r * EV_NP]);
    KM[(((size_t)b * 8 + (col >> 6)) * 8 + n) * 64 + (col & 63)] = (bf16)f2bf(s * (1.f / 256.f));
}
DI void phase_index(const Ptrs& P, LAS unsigned char* lds) {
    for (int u = P.bid; u < 64; u += P.G) kmean_unit(P, u & 7, u >> 3);
    for (int k = 0; ; ++k) { const int u = P.bid + P.G * k; if (u >= 1024) break;
        const int b = u & 7, v = u >> 3, kq = v >> 5, a = v & 31; const int idx = (kq == 0) ? a : (kq == 1) ? 127 - a : (kq == 2) ? 32 + a : 95 - a;
        idx_unit(P, lds, b, idx); }
}

constexpr int KROW = 144;
constexpr float M_INIT = -1.0e30f;
DI f32x16 mfma32(bf16x8 a, bf16x8 b, f32x16 c) { return __builtin_amdgcn_mfma_f32_32x32x16_bf16(a, b, c, 0, 0, 0); }
typedef short v4i16_t __attribute__((ext_vector_type(4)));
DI s16x4 vtr(const LAS unsigned char* p) { return __builtin_bit_cast(s16x4, __builtin_amdgcn_ds_read_tr16_b64_v4i16((LAS v4i16_t*)p)); }
typedef __bf16 bf16x2_t __attribute__((ext_vector_type(2)));
DI unsigned cvtpk(float lo, float hi) { const f32x2 v = {lo, hi}; const bf16x2_t b = __builtin_convertvector(v, bf16x2_t); return __builtin_bit_cast(unsigned, b); }
DI void swap32(unsigned& a, unsigned& b) { asm volatile("s_nop 1\n\tv_permlane32_swap_b32 %0, %1\n\ts_nop 1" : "+v"(a), "+v"(b)); }
DI float xhalf_max(float m) { unsigned a = __builtin_bit_cast(unsigned, m), b = a; swap32(a, b); return fmaxf(__builtin_bit_cast(float, a), __builtin_bit_cast(float, b)); }
DI float xhalf_sum(float m) { unsigned a = __builtin_bit_cast(unsigned, m), b = a; swap32(a, b); return __builtin_bit_cast(float, a) + __builtin_bit_cast(float, b); }
DI int crow(int r, int hi) { return (r & 3) + 8 * (r >> 2) + 4 * hi; }

struct AState { float m, l; f32x16 o0, o1; };
DI void astate_init(AState& s) { s.m = M_INIT; s.l = 0.f;
#pragma unroll
    for (int r = 0; r < 16; ++r) { s.o0[r] = 0.f; s.o1[r] = 0.f; } }

template <class MaskF>
DI void attn_tile(AState& st, const LAS unsigned char* kt, const LAS unsigned char* vt, int vd0, const bf16x8 (&qr)[4], LAS float* wsf, int lane, MaskF&& mask) {
    const int r32 = lane & 31, hi = lane >> 5;
    f32x16 p0, p1;
#pragma unroll
    for (int r = 0; r < 16; ++r) { p0[r] = 0.f; p1[r] = 0.f; }
    const LAS unsigned char* kb = kt + r32 * KROW + hi * 16;
#pragma unroll
    for (int d0 = 0; d0 < 4; ++d0) { const bf16x8 a0 = *(const LAS bf16x8*)(kb + d0 * 32), a1 = *(const LAS bf16x8*)(kb + 32 * KROW + d0 * 32);
        p0 = mfma32(a0, qr[d0], p0); p1 = mfma32(a1, qr[d0], p1); }
    mask(p0, p1);
    float rm = fmaxf(p0[0], p1[0]);
#pragma unroll
    for (int r = 1; r < 16; ++r) rm = fmaxf(rm, fmaxf(p0[r], p1[r]));
    rm = xhalf_max(rm);
    if (__any(rm > st.m)) {
        const float mn = fmaxf(st.m, rm), al = __builtin_amdgcn_exp2f(st.m - mn); st.l *= al; st.m = mn;
        if (hi == 0) wsf[r32] = al;
        asm volatile("s_waitcnt lgkmcnt(0)" ::: "memory");
#pragma unroll
        for (int g = 0; g < 4; ++g) { const f32x4 a4 = *(const LAS f32x4*)(wsf + 8 * g + 4 * hi);
#pragma unroll
            for (int i = 0; i < 4; ++i) { st.o0[4 * g + i] *= a4[i]; st.o1[4 * g + i] *= a4[i]; } }
    }
    float sacc = 0.f;
#pragma unroll
    for (int r = 0; r < 16; ++r) { p0[r] = __builtin_amdgcn_exp2f(p0[r] - st.m); p1[r] = __builtin_amdgcn_exp2f(p1[r] - st.m); sacc += p0[r] + p1[r]; }
    st.l += sacc;
    const LAS unsigned char* vb = vt + (4 * hi + ((lane & 15) >> 2)) * 64 + ((lane >> 4) & 1) * 32 + (lane & 3) * 8;
#pragma unroll
    for (int sub = 0; sub < 2; ++sub)
#pragma unroll
        for (int ks = 0; ks < 2; ++ks) {
            u32x4 pw;
            if (sub == 0) { pw.x = cvtpk(p0[8 * ks], p0[8 * ks + 1]); pw.y = cvtpk(p0[8 * ks + 2], p0[8 * ks + 3]); pw.z = cvtpk(p0[8 * ks + 4], p0[8 * ks + 5]); pw.w = cvtpk(p0[8 * ks + 6], p0[8 * ks + 7]); }
            else          { pw.x = cvtpk(p1[8 * ks], p1[8 * ks + 1]); pw.y = cvtpk(p1[8 * ks + 2], p1[8 * ks + 3]); pw.z = cvtpk(p1[8 * ks + 4], p1[8 * ks + 5]); pw.w = cvtpk(p1[8 * ks + 6], p1[8 * ks + 7]); }
            const bf16x8 pa = __builtin_bit_cast(bf16x8, pw);
            const LAS unsigned char* vr = vb + (32 * sub + 16 * ks) * 64;
            { const s16x4 lo = vtr(vr), hh = vtr(vr + 8 * 64); const bf16x8 vf = {lo[0], lo[1], lo[2], lo[3], hh[0], hh[1], hh[2], hh[3]}; st.o0 = mfma32(pa, vf, st.o0); }
            { const s16x4 lo = vtr(vr + vd0), hh = vtr(vr + vd0 + 8 * 64); const bf16x8 vf = {lo[0], lo[1], lo[2], lo[3], hh[0], hh[1], hh[2], hh[3]}; st.o1 = mfma32(pa, vf, st.o1); }
        }
}
template <class RowF>
DI float attn_finish(AState& st, LAS float* wsf, int lane, RowF&& rowp) {
    const int r32 = lane & 31, hi = lane >> 5;
    const float lt = xhalf_sum(st.l);
    if (hi == 0) wsf[32 + r32] = lt;
    asm volatile("s_waitcnt lgkmcnt(0)" ::: "memory");
#pragma unroll
    for (int g = 0; g < 4; ++g) { const f32x4 l4 = *(const LAS f32x4*)(wsf + 32 + 8 * g + 4 * hi);
#pragma unroll
        for (int i = 0; i < 4; ++i) { const float inv = 1.0f / l4[i]; bf16* o = rowp(8 * g + 4 * hi + i);
#ifdef DBG_L
            { const float L = l4[i]; const float a0 = st.o0[4 * g + i], a1 = st.o1[4 * g + i]; const bool obad = !(fabsf(a0) < 1e30f) || !(fabsf(a1) < 1e30f);
              const float c = (L == 0.f) ? 32.f : (L != L) ? 512.f : (fabsf(L) > 1e30f) ? 128.f : (L < 0.99f) ? 2048.f : obad ? 8192.f : 0.f; o[r32] = (bf16)f2bf(c); o[32 + r32] = (bf16)f2bf(c); }
#else
            o[r32] = (bf16)f2bf(st.o0[4 * g + i] * inv); o[32 + r32] = (bf16)f2bf(st.o1[4 * g + i] * inv);
#endif
            } }
    return lt;
}
struct TileRegs { u32x4 k, v; };
DI void tile_load(TileRegs& r, const bf16* krow, const bf16* vrow, int chunk) { r.k = *(const u32x4*)(krow + chunk * 8); r.v = *(const u32x4*)(vrow + chunk * 8); }
DI void tile_store(LAS unsigned char* kt, LAS unsigned char* vt, int vd0, const TileRegs& r, int key, int chunk) {
    *(LAS u32x4*)(kt + key * KROW + chunk * 16) = r.k;
    *(LAS u32x4*)(vt + (chunk >> 2) * vd0 + key * 64 + (chunk & 3) * 16) = r.v;
}
constexpr int AT_K = 64 * KROW, AT_V = 2 * 64 * 64, AT_BUF = AT_K + AT_V;
constexpr int AT_WSF = 2 * AT_BUF;
constexpr int AT_EXTRA = AT_WSF + NWAVES * 256;
DI void load_q(bf16x8 (&qr)[4], const bf16* qrowp  , int hi) {
#pragma unroll
    for (int d0 = 0; d0 < 4; ++d0) qr[d0] = *(const bf16x8*)(qrowp + d0 * 16 + hi * 8);
}
template <class KV, class Act, class MaskT>
DI void attn_run(AState& st, LAS unsigned char* lds, const bf16x8 (&qr)[4], int nt, int tid, int lane, int wave, KV&& kv, Act&& act, MaskT&& mask) {
    const int key = tid >> 3, chunk = tid & 7;
    LAS unsigned char* buf0 = lds; LAS unsigned char* buf1 = lds + AT_BUF; LAS float* wsf = (LAS float*)(lds + AT_WSF) + wave * 64;
    TileRegs tr; const bf16* kp; const bf16* vp;
    kv(0, key, kp, vp); tile_load(tr, kp, vp, chunk); tile_store(buf0, buf0 + AT_K, 4096, tr, key, chunk);
    __syncthreads();
    for (int t = 0; t < nt; ++t) {
        LAS unsigned char* cur = (t & 1) ? buf1 : buf0; LAS unsigned char* nxt = (t & 1) ? buf0 : buf1;
        const bool more = t + 1 < nt;
        if (more) { kv(t + 1, key, kp, vp); tile_load(tr, kp, vp, chunk); }
        if (act(t)) attn_tile(st, cur, cur + AT_K, 4096, qr, wsf, lane, [&](f32x16& p0, f32x16& p1) { mask(t, p0, p1); });
        if (more) tile_store(nxt, nxt + AT_K, 4096, tr, key, chunk);
        __syncthreads();
    }
}
#define CR(r) (((r) & 3) + 8 * ((r) >> 2))
DI void dsa_unit(const Ptrs& P, LAS unsigned char* lds, int b, int qb32) {
    const bf16* PROJ = (const bf16*)(P.ws + WS_R1); const unsigned* MASK = (const unsigned*)(P.ws + WS_MASK); bf16* O = (bf16*)(P.ws + WS_O);
    const int lane = P.lane, r32 = lane & 31, hi = lane >> 5, t0 = 32 * qb32; const size_t rowbase = (size_t)b * SEQ;
    LAS unsigned* ml = (LAS unsigned*)(lds + AT_EXTRA);
#pragma unroll
    for (int k = 0; k < 4; ++k) { const int idx = P.tid + NTHR * k, row = idx >> 6, j = idx & 63; ml[j * 33 + row] = MASK[(rowbase + t0 + row) * 64 + j]; }
    bf16x8 qr[4]; load_q(qr, PROJ + (rowbase + t0 + r32) * EV_NP + C_QA + P.wave * 64, hi);
    AState st; astate_init(st);
    const int nt = (t0 + 32 + 63) >> 6;
    attn_run(st, lds, qr, nt, P.tid, lane, P.wave,
        [&](int t, int key, const bf16*& kp, const bf16*& vp) { const bf16* rp = PROJ + (rowbase + 64 * t + key) * EV_NP; kp = rp + C_KA; vp = rp + C_VA; },
        [&](int) { return true; },
        [&](int t, f32x16& p0, f32x16& p1) { const unsigned w0 = ml[(2 * t) * 33 + r32] >> (4 * hi), w1 = ml[(2 * t + 1) * 33 + r32] >> (4 * hi);
#pragma unroll
            for (int r = 0; r < 16; ++r) { if (!((w0 >> CR(r)) & 1u)) p0[r] = -INFINITY; if (!((w1 >> CR(r)) & 1u)) p1[r] = -INFINITY; } });
    LAS float* wsf = (LAS float*)(lds + AT_WSF) + P.wave * 64;
    (void)attn_finish(st, wsf, lane, [&](int rr) { return O + (rowbase + t0 + rr) * DM + P.wave * 64; });
}
DI void moba_unit(const Ptrs& P, LAS unsigned char* lds, int b, int h, int n) {
    const bf16* PROJ = (const bf16*)(P.ws + WS_R1); const bf16* KM = (const bf16*)(P.ws + WS_MISC + MS_KM); bf16* O = (bf16*)(P.ws + WS_O);
    const int lane = P.lane, r32 = lane & 31, hi = lane >> 5; const size_t rowbase = (size_t)b * SEQ; const int q0 = 256 * n + 32 * P.wave;
    bf16x8 qr[4]; load_q(qr, PROJ + (rowbase + q0 + r32) * EV_NP + C_QB + h * 64, hi);
    unsigned sel = 0u;
    if (n > 0) {
        f32x16 g;
#pragma unroll
        for (int r = 0; r < 16; ++r) g[r] = 0.f;
        const bf16* kmr = KM + (((size_t)b * 8 + h) * 8 + (r32 & 7)) * 64;
#pragma unroll
        for (int d0 = 0; d0 < 4; ++d0) { bf16x8 a = *(const bf16x8*)(kmr + d0 * 16 + hi * 8); if (r32 >= 8) a = (bf16x8){0, 0, 0, 0, 0, 0, 0, 0}; g = mfma32(a, qr[d0], g); }
        float gt[8];
#pragma unroll
        for (int i = 0; i < 4; ++i) { const float own = g[i], oth = __shfl_xor(own, 32); gt[i] = hi ? oth : own; gt[4 + i] = hi ? own : oth; }
#pragma unroll
        for (int round = 0; round < 3; ++round) if (round < n) { float best = -INFINITY; int bi = -1;
#pragma unroll
            for (int j = 0; j < 8; ++j) if (j < n && !((sel >> j) & 1u) && gt[j] > best) { best = gt[j]; bi = j; }
            if (bi >= 0) sel |= 1u << bi; }
    }
    AState st; astate_init(st);
    const int nt = 4 * n + 4;
    attn_run(st, lds, qr, nt, P.tid, lane, P.wave,
        [&](int t, int key, const bf16*& kp, const bf16*& vp) { const bf16* rp = PROJ + (rowbase + 64 * t + key) * EV_NP + h * 64; kp = rp + C_KB; vp = rp + C_VB; },
        [&](int t) { const int blk = t >> 2; if (blk < n) return __any((sel >> blk) & 1u) != 0; return 64 * (t - 4 * n) <= 32 * P.wave + 31; },
        [&](int t, f32x16& p0, f32x16& p1) { const int blk = t >> 2;
            if (blk < n) { if (!((sel >> blk) & 1u)) {
#pragma unroll
                    for (int r = 0; r < 16; ++r) { p0[r] = -INFINITY; p1[r] = -INFINITY; } } }
            else { const int kb = 64 * (t - 4 * n) + 4 * hi, qrel = 32 * P.wave + r32;
#pragma unroll
                for (int r = 0; r < 16; ++r) { if (kb + CR(r) > qrel) p0[r] = -INFINITY; if (kb + 32 + CR(r) > qrel) p1[r] = -INFINITY; } } });
    LAS float* wsf = (LAS float*)(lds + AT_WSF) + P.wave * 64;
    (void)attn_finish(st, wsf, lane, [&](int rr) { return O + (rowbase + q0 + rr) * DM + 512 + h * 64; });
}
DI void phase_attn_even(const Ptrs& P, LAS unsigned char* lds) {
    for (int k = 0; ; ++k) { const int u = P.bid + P.G * k; if (u >= 512) break;
        const int b = u & 7, v = u >> 3, a = v & 31; dsa_unit(P, lds, b, (v >> 5) ? 63 - a : a); }
    for (int k = 0; ; ++k) { const int u = P.bid + P.G * k; if (u >= 512) break;
        const int b = u & 7, h = (u >> 3) & 7, v = u >> 6; moba_unit(P, lds, b, h, v < 4 ? v : 11 - v); }
}
constexpr int B3_K = 128 * KROW, B3_V = 2 * 128 * 64, B3_HALF = B3_K + B3_V, B3_WSF = 2 * B3_HALF;
DI void b3_unit(const Ptrs& P, LAS unsigned char* lds, int b, int h, int rp) {
    const bf16* PROJ = (const bf16*)(P.ws + WS_R1); bf16* O = (bf16*)(P.ws + WS_O); float* LSE3 = (float*)(P.ws + WS_MISC + MS_LSE3);
    const int lane = P.lane, r32 = lane & 31, hi = lane >> 5, half = P.wave >> 2, wi = P.wave & 3, r16 = 2 * rp + half; const size_t rowbase = (size_t)b * SEQ;
    LAS unsigned char* kh = lds + half * B3_HALF; LAS unsigned char* vh = kh + B3_K;
    const int th = P.tid & 255;
#pragma unroll
    for (int k = 0; k < 4; ++k) { const int idx = th + 256 * k, key = idx >> 3, chunk = idx & 7; const bf16* rpn = PROJ + (rowbase + 16 * key + r16) * OD_N + h * 64;
        TileRegs tr; tile_load(tr, rpn + OC_K, rpn + OC_V, chunk); tile_store(kh, vh, 128 * 64, tr, key, chunk); }
    bf16x8 qr[4]; load_q(qr, PROJ + (rowbase + 16 * (32 * wi + r32) + r16) * OD_N + OC_Q + h * 64, hi);
    __syncthreads();
    AState st; astate_init(st);
    LAS float* wsf = (LAS float*)(lds + B3_WSF) + P.wave * 64;
    for (int T = 0; T <= (wi >> 1); ++T)
        attn_tile(st, kh + 64 * T * KROW, vh + 64 * T * 64, 128 * 64, qr, wsf, lane, [&](f32x16& p0, f32x16& p1) { const int kb = 64 * T + 4 * hi, wq = 32 * wi + r32;
#pragma unroll
            for (int r = 0; r < 16; ++r) { if (kb + CR(r) > wq) p0[r] = -INFINITY; if (kb + 32 + CR(r) > wq) p1[r] = -INFINITY; } });
    const float lt = attn_finish(st, wsf, lane, [&](int rr) { return O + (rowbase + 16 * (32 * wi + rr) + r16) * DM + h * 64; });
    if (hi == 0) LSE3[(rowbase + 16 * (32 * wi + r32) + r16) * 16 + h] = st.m + __builtin_amdgcn_logf(lt);
    __syncthreads();
}
DI void phase_b3(const Ptrs& P, LAS unsigned char* lds) {
    for (int k = 0; ; ++k) { const int u = P.bid + P.G * k; if (u >= 1024) break; b3_unit(P, lds, u & 7, (u >> 3) & 15, u >> 7); }
}
DI void band_unit(const Ptrs& P, LAS unsigned char* lds, int b, int h, int qb) {
    const bf16* PROJ = (const bf16*)(P.ws + WS_R1); bf16* O = (bf16*)(P.ws + WS_O); const float* LSE3 = (const float*)(P.ws + WS_MISC + MS_LSE3);
    const int lane = P.lane, r32 = lane & 31, hi = lane >> 5; const size_t rowbase = (size_t)b * SEQ; const int t0w = 256 * qb + 32 * P.wave;
    bf16x8 qr[4]; load_q(qr, PROJ + (rowbase + t0w + r32) * OD_N + OC_Q + h * 64, hi);
    AState st; st.m = LSE3[(rowbase + t0w + r32) * 16 + h]; st.l = hi ? 0.f : 1.f;
#pragma unroll
    for (int r = 0; r < 16; ++r) { const bf16* orow = O + (rowbase + t0w + CR(r) + 4 * hi) * DM + h * 64 + r32; st.o0[r] = bf2f(orow[0]); st.o1[r] = bf2f(orow[32]); }
    const int kt_lo = (4 * qb - 8 > 0) ? 4 * qb - 8 : 0, nt = 4 * qb + 4 - kt_lo;
    attn_run(st, lds, qr, nt, P.tid, lane, P.wave,
        [&](int t, int key, const bf16*& kp, const bf16*& vp) { const bf16* rp = PROJ + (rowbase + 64 * (kt_lo + t) + key) * OD_N + h * 64; kp = rp + OC_K; vp = rp + OC_V; },
        [&](int t) { const int k0 = 64 * (kt_lo + t); return (k0 + 63 >= t0w - 512) && (k0 <= t0w + 31); },
        [&](int t, f32x16& p0, f32x16& p1) { const int dq = (t0w + r32) - (64 * (kt_lo + t) + 4 * hi);
#pragma unroll
            for (int r = 0; r < 16; ++r) {
                { const int d = dq - CR(r); const int mult = ((unsigned)d <= 128u ? 1 : 0) + (((unsigned)d <= 512u && (d & 3) == 0) ? 1 : 0); p0[r] = mult == 0 ? -INFINITY : (mult == 2 ? p0[r] + 1.0f : p0[r]); }
                { const int d = dq - 32 - CR(r); const int mult = ((unsigned)d <= 128u ? 1 : 0) + (((unsigned)d <= 512u && (d & 3) == 0) ? 1 : 0); p1[r] = mult == 0 ? -INFINITY : (mult == 2 ? p1[r] + 1.0f : p1[r]); } } });
    LAS float* wsf = (LAS float*)(lds + AT_WSF) + P.wave * 64;
    (void)attn_finish(st, wsf, lane, [&](int rr) { return O + (rowbase + t0w + rr) * DM + h * 64; });
}
DI void phase_band(const Ptrs& P, LAS unsigned char* lds) {
    for (int k = 0; ; ++k) { const int u = P.bid + P.G * k; if (u >= 1024) break; band_unit(P, lds, u & 7, (u >> 3) & 15, u >> 7); }
}

struct Args { const float* in[20]; float* out; unsigned char* ws; int ph_lo, ph_hi; };
constexpr int NPH_PAIR = 21, NPH = 2 * NPH_PAIR;
constexpr int PT_OFF = LDS_BYTES - 512;
DI unsigned long long uni64(unsigned long long v) { const unsigned lo = __builtin_amdgcn_readfirstlane((unsigned)v), hi = __builtin_amdgcn_readfirstlane((unsigned)(v >> 32)); return ((unsigned long long)hi << 32) | lo; }
DI Ptrs load_ptrs(LAS unsigned char* lds) {
    Ptrs P; const LAS unsigned long long* t = (const LAS unsigned long long*)(lds + PT_OFF);
#pragma unroll
    for (int i = 0; i < 20; ++i) P.in[i] = (const float*)uni64(t[i]);
    P.out = (float*)uni64(t[20]); P.ws = (unsigned char*)uni64(t[21]);
    int tid_ = threadIdx.x; asm volatile("" : "+v"(tid_)); P.tid = tid_; P.lane = P.tid & 63; P.wave = __builtin_amdgcn_readfirstlane(P.tid >> 6); P.bid = blockIdx.x; P.G = gridDim.x;
    return P;
}
DI void grid_bar(LAS unsigned char* lds) {
    const Ptrs P = load_ptrs(lds);
    XcdBarrier bar; bar.bar = (unsigned*)(P.ws + WS_CTL) + CW_BAR; bar.x = xb_xcc_id(); bar.st = (volatile LAS unsigned*)(lds + LDS_BYTES - 16);
    xcd_barrier(bar);
}
__global__ void __launch_bounds__(NTHR, 2) fwd(Args args) {
    extern __shared__ __attribute__((aligned(16))) unsigned char lds_raw[];
    LAS unsigned char* lds = (LAS unsigned char*)lds_raw;
    const int lo = args.ph_lo, hi = args.ph_hi;
    {   LAS unsigned long long* t = (LAS unsigned long long*)(lds + PT_OFF);
        if (threadIdx.x == 0) {
#pragma unroll
            for (int i = 0; i < 20; ++i) t[i] = (unsigned long long)args.in[i];
            t[20] = (unsigned long long)args.out; t[21] = (unsigned long long)args.ws; }
        volatile LAS unsigned* bst = (volatile LAS unsigned*)(lds + LDS_BYTES - 16);
        if (threadIdx.x == 0) { bst[0] = 0u; bst[1] = 0u; }
        __syncthreads();
        if (hi - lo > 1) (void)xcd_barrier_post((unsigned*)(args.ws + WS_CTL) + CW_BAR, bst);
    }
#define PTRS() const Ptrs P = load_ptrs(lds); bf16* WIN = (bf16*)(P.ws + WS_WIN); bf16* WOUT = (bf16*)(P.ws + WS_WOUT); bf16* WUP = (bf16*)(P.ws + WS_WUP); bf16* WDN = (bf16*)(P.ws + WS_WDN); \
    float* XF = (float*)(P.ws + WS_XF); bf16* XB = (bf16*)(P.ws + WS_XB); bf16* PROJ = (bf16*)(P.ws + WS_R1); bf16* OB = (bf16*)(P.ws + WS_O); bf16* HB = (bf16*)(P.ws + WS_R1); \
    float* MIX = (float*)(P.ws + WS_MIX); bf16* XBUF = (bf16*)(P.ws + WS_XBUF); const int* pblk = (const int*)(P.ws + WS_MISC + MS_PBLK); \
    (void)WIN; (void)WOUT; (void)WUP; (void)WDN; (void)XF; (void)XB; (void)PROJ; (void)OB; (void)HB; (void)MIX; (void)XBUF; (void)pblk;

    for (int pair = 0; pair < 2; ++pair) {
        const int base = pair * NPH_PAIR;
#ifndef PHMASK
#define PHMASK 0x1fffff
#endif
#define IN(k) (((PHMASK >> (k)) & 1) && lo <= base + (k) && base + (k) < hi)
#define SEAM(k) do { if (base + (k) + 1 < hi) grid_bar(lds); } while (0)
        if (IN(0)) { PTRS(); if (pair == 0) phase_init(P); phase_convert_even(P, lds, pair); SEAM(0); }
        if (IN(1)) { PTRS(); pg8::Gemm g{XB, WIN, NTOK, EV_NP, DM}; pg8::StaticOrder S; S.init(NTOK, EV_NP, P.G, P.bid); pg8::EpiStoreBf16 E{PROJ, EV_NP};
            pg8::gemm_phase<pg8::EpiStoreBf16, pg8::StaticOrder, true, true>(lds, g, S, E); SEAM(1); }
        if (IN(2)) { PTRS(); phase_rope_even(P); SEAM(2); }
        if (IN(3)) { PTRS(); phase_index(P, lds); SEAM(3); }
        if (IN(4)) { PTRS(); phase_attn_even(P, lds); SEAM(4); }
        if (IN(5)) { PTRS(); pg8::Gemm g{OB, WOUT, NTOK, DM, DM}; pg8::StaticOrder S; S.init(NTOK, DM, P.G, P.bid); pg8::EpiF32 E{MIX, DM, pair == 0 ? P.in[0] : (const float*)XF, ALPHA};
            pg8::gemm_phase<pg8::EpiF32, pg8::StaticOrder, true, true>(lds, g, S, E); SEAM(5); }
        if (IN(6)) { PTRS(); phase_ln<false>(P, lds, P.in[3] + pair * DM, P.in[4] + pair * DM, XF, XB, nullptr); SEAM(6); }
        if (IN(7)) { PTRS(); pg8::Gemm g{XB, WUP, NTOK, 2 * FF, DM}; pg8::StaticOrder S; S.init(NTOK, 2 * FF, P.G, P.bid); pg8::EpiSwiGLU E{HB, FF};
            pg8::gemm_phase<pg8::EpiSwiGLU, pg8::StaticOrder, true, true>(lds, g, S, E); SEAM(7); }
        if (IN(8)) { PTRS(); pg8::Gemm g{HB, WDN, NTOK, DM, FF}; pg8::StaticOrder S; S.init(NTOK, DM, P.G, P.bid); pg8::EpiF32 E{MIX, DM, XF, ALPHA};
            pg8::gemm_phase<pg8::EpiF32, pg8::StaticOrder, true, true>(lds, g, S, E); SEAM(8); }
        if (IN(9)) { PTRS(); phase_ln<false>(P, lds, P.in[8] + pair * DM, P.in[9] + pair * DM, XF, XB, nullptr); SEAM(9); }
        if (IN(10)) { PTRS(); phase_convert_odd(P, lds, pair); SEAM(10); }
        if (IN(11)) { PTRS(); pg8::Gemm g{XB, WIN, NTOK, OD_N, DM}; pg8::StaticOrder S; S.init(NTOK, OD_N, P.G, P.bid); pg8::EpiStoreBf16 E{PROJ, OD_N};
            pg8::gemm_phase<pg8::EpiStoreBf16, pg8::StaticOrder, true, true>(lds, g, S, E); SEAM(11); }
        if (IN(12)) { PTRS(); phase_rope_odd(P); SEAM(12); }
        if (IN(13)) { PTRS(); phase_b3(P, lds); SEAM(13); }
        if (IN(14)) { PTRS(); phase_band(P, lds); SEAM(14); }
        if (IN(15)) { PTRS(); pg8::Gemm g{OB, WOUT, NTOK, DM, DM}; pg8::StaticOrder S; S.init(NTOK, DM, P.G, P.bid); pg8::EpiF32 E{MIX, DM, XF, ALPHA};
            pg8::gemm_phase<pg8::EpiF32, pg8::StaticOrder, true, true>(lds, g, S, E); SEAM(15); }
        if (IN(16)) { PTRS(); phase_ln<true>(P, lds, P.in[12] + pair * DM, P.in[13] + pair * DM, XF, XB, P.in[14] + (size_t)pair * DM * NEXP); SEAM(16); }
        if (IN(17)) { PTRS(); phase_route(P, lds); SEAM(17); }
        if (IN(18)) { PTRS(); pg8::Gemm g{XBUF, WUP, MOE_ROWS, 2 * FFE, DM}; pg8::MoeOrder S; S.init(pblk, 2 * FFE / 256, (long)2 * FFE * DM * 2, P.G, P.bid); pg8::EpiSwiGLU E{HB, FFE};
            pg8::gemm_phase<pg8::EpiSwiGLU, pg8::MoeOrder, true, true>(lds, g, S, E); SEAM(18); }
        if (IN(19)) { PTRS(); pg8::Gemm g{HB, WDN, MOE_ROWS, DM, FFE}; pg8::MoeOrder S; S.init(pblk, DM / 256, (long)DM * FFE * 2, P.G, P.bid); pg8::EpiF32 E{MIX, DM, nullptr, 0.f};
            pg8::gemm_phase<pg8::EpiF32, pg8::MoeOrder, true, true>(lds, g, S, E); SEAM(19); }
        if (IN(20)) { PTRS(); phase_moe_combine(P, P.in[18] + pair * DM, P.in[19] + pair * DM, pair == 1 ? P.out : XF, pair == 1 ? nullptr : XB); SEAM(20); }
#undef IN
#undef SEAM
    }
}

#ifdef DBG_STOP
__global__ void dbg_dump(float* out, const unsigned char* ws, const float* x, int src) {
    const size_t n = (size_t)NTOK * DM;
    for (size_t i = (size_t)blockIdx.x * blockDim.x + threadIdx.x; i < n; i += (size_t)gridDim.x * blockDim.x) {
        float v;
        switch (src) {
            case 0: v = x[i]; break;
            case 1: v = bf2f(((const bf16*)(ws + WS_XB))[i]); break;
            case 2: v = bf2f(((const bf16*)(ws + WS_R1))[i]); break;
            case 3: v = ((const float*)(ws + WS_MIX))[i]; break;
            case 4: v = ((const float*)(ws + WS_XF))[i]; break;
            case 5: v = bf2f(((const bf16*)(ws + WS_O))[i]); break;
            case 8: { const float o = bf2f(((const bf16*)(ws + WS_O))[i]); const bool bad = !(fabsf(o) < 1e30f); v = ((i & 1023) < 512) ? (bad ? 1000.f : 0.f) : 0.f; } break;
            case 10: { const float o = bf2f(((const bf16*)(ws + WS_O))[i]); const bool bad = !(fabsf(o) < 1e30f); const int t = (int)((i >> 10) & 2047); v = ((i & 1023) < 512 && bad) ? 32.f * (float)(1 << (t >> 8)) : 0.f; } break;
            case 11: { const float o = bf2f(((const bf16*)(ws + WS_O))[i]); const bool bad = !(fabsf(o) < 1e30f); const int b = (int)(i >> 21); v = ((i & 1023) < 512 && bad) ? 32.f * (float)(1 << b) : 0.f; } break;
            case 12: { const float o = bf2f(((const bf16*)(ws + WS_O))[i]); const bool bad = !(fabsf(o) < 1e30f); const int t = (int)((i >> 10) & 2047); v = ((i & 1023) < 512 && bad) ? 32.f * (float)(1 << ((t >> 5) & 7)) : 0.f; } break;
            case 13: { const float o = bf2f(((const bf16*)(ws + WS_O))[i]); const bool bad = !(fabsf(o) < 1e30f); const int hh = (int)((i >> 6) & 7); v = ((i & 1023) < 512 && bad) ? 32.f * (float)(1 << hh) : 0.f; } break;
            case 14: { v = 0.f; if ((i & 1023) == 0) { const int row = (int)(i >> 10); int cnt = 0; for (int w = 0; w < 64; ++w) cnt += __popc(((const unsigned*)(ws + WS_MASK))[row * 64 + w]); const int t = row & 2047; const int ex = t + 1 < 256 ? t + 1 : 256; v = (cnt != ex) ? 1000.f : 0.f; } } break;
            case 15: { const float o = bf2f(((const bf16*)(ws + WS_O))[i]); v = ((i & 1023) < 512) ? o : 0.f; } break;
            case 9: { const float o = bf2f(((const bf16*)(ws + WS_O))[i]); const bool bad = !(fabsf(o) < 1e30f); v = ((i & 1023) >= 512) ? (bad ? 1000.f : 0.f) : 0.f; } break;
            case 6: v = (float)(((const unsigned*)(ws + WS_MASK))[i & (NTOK * 64 - 1)] & 0xffffu); break;
            case 7: v = bf2f(((const bf16*)(ws + WS_WUP))[i]); break;
            default: v = 0.f;
        }
        out[i] = v;
    }
}
#endif
#ifndef MK_SPLIT
#define MK_SPLIT 1
#endif
extern "C" void kernel_launch(void* const* d_in, const int* in_sizes, int n_in, void* d_out, int out_size, void* d_ws, size_t ws_size, hipStream_t stream) {
    static int grid = 0;
    if (grid == 0) {
        if (n_in != 20 || in_sizes[0] != NTOK * DM || out_size != NTOK * DM || ws_size < WS_END) { fprintf(stderr, "kernel_launch: unexpected problem (n_in %d, in0 %d, out %d, ws %zu); nothing launched\n", n_in, n_in > 0 ? in_sizes[0] : -1, out_size, ws_size); grid = -1; return; }
        int dev = 0, cus = 0, per_cu = 0;
        if (hipGetDevice(&dev) != hipSuccess || hipDeviceGetAttribute(&cus, hipDeviceAttributeMultiprocessorCount, dev) != hipSuccess) { grid = -1; return; }
        if (hipFuncSetAttribute((const void*)fwd, hipFuncAttributeMaxDynamicSharedMemorySize, LDS_BYTES) != hipSuccess) { fprintf(stderr, "kernel_launch: hipFuncSetAttribute failed\n"); grid = -1; return; }
        if (hipOccupancyMaxActiveBlocksPerMultiprocessor(&per_cu, (const void*)fwd, NTHR, LDS_BYTES) != hipSuccess || per_cu < 1) fprintf(stderr, "kernel_launch: note: occupancy query reports %d\n", per_cu);
        (void)hipGetLastError();
        grid = cus;
    }
    if (grid < 0) return;
    if (hipMemsetAsync((char*)d_ws + WS_CTL, 0, CTL_ZERO_BYTES, stream) != hipSuccess) return;
    Args a{};
    for (int i = 0; i < 20; ++i) a.in[i] = (const float*)d_in[i];
    a.out = (float*)d_out; a.ws = (unsigned char*)d_ws;
#ifdef DBG_STOP
    for (int p = 0; p < DBG_STOP; ++p) { a.ph_lo = p; a.ph_hi = p + 1; hipLaunchKernelGGL(fwd, dim3(grid), dim3(NTHR), LDS_BYTES, stream, a); }
    hipLaunchKernelGGL(dbg_dump, dim3(1024), dim3(256), 0, stream, (float*)d_out, (const unsigned char*)d_ws, (const float*)d_in[0], (int)DBG_SRC);
#elif MK_SPLIT
    for (int p = 0; p < NPH; ++p) { a.ph_lo = p; a.ph_hi = p + 1; hipLaunchKernelGGL(fwd, dim3(grid), dim3(NTHR), LDS_BYTES, stream, a); }
#else
    a.ph_lo = 0; a.ph_hi = NPH; hipLaunchKernelGGL(fwd, dim3(grid), dim3(NTHR), LDS_BYTES, stream, a);
#endif
}
```

```cpp
#include <hip/hip_runtime.h>
#include <cstdio>
#include <cstdint>
#define MK_SPLIT 0
namespace pg8 {
#define PG8_LAS __attribute__((address_space(3)))
typedef unsigned short bf16_t;
typedef short bf16x8 __attribute__((ext_vector_type(8)));
typedef float f32x4 __attribute__((ext_vector_type(4)));
typedef unsigned u32x4 __attribute__((ext_vector_type(4)));
constexpr int BM = 256, BK = 64, HALF = 128, HTB = HALF * BK * 2  , STAGE_BYTES = 8 * HTB, NXCD = 8, WGM = 8;

__host__ __device__ __forceinline__ int lds_byte(int r, int c) { const int st = (r >> 4) * 2 + (c >> 5), rr = r & 15, cc = c & 31, ob = rr * 64 + cc * 2; return st * 1024 + (ob ^ (((ob >> 9) & 1) << 5)); }
__host__ __device__ __forceinline__ void stage_rc(int b, int& R, int& C) { const int st = b / 1024, sb = b % 1024, swz = sb ^ (((sb >> 9) & 1) << 5); R = (st >> 1) * 16 + swz / 64; C = (st & 1) * 32 + (swz % 64) / 2; }
__host__ __device__ __forceinline__ int perm32(int rho) { const int n = rho >> 4, i = rho & 15; return 8 * (i >> 2) + 4 * n + (i & 3); }

struct Unit { int pm, pn; long boff; };
struct Gemm { const bf16_t* A; const bf16_t* Bt; int M, N, K; };

struct StaticOrder {
    int nM, nN, nwg, G, c;
    __host__ __device__ void init(int M, int N, int G_, int c_) { nM = M / BM; nN = N / BM; nwg = nM * nN; G = G_; c = c_; }
    __host__ __device__ bool next(int i, Unit& u) const {
        const long L = (long)i * G + c; if (L >= nwg) return false;
        int wgid = (int)L; { const int q = nwg / NXCD, r = nwg % NXCD, xcd = wgid % NXCD, off = wgid / NXCD; wgid = (xcd < r ? xcd * (q + 1) : r * (q + 1) + (xcd - r) * q) + off; }
        const int nig = WGM * nN, gid = wgid / nig, fm = gid * WGM, gsz = (nM - fm) < WGM ? (nM - fm) : WGM;
        u.pm = fm + ((wgid % nig) % gsz); u.pn = (wgid % nig) / gsz; u.boff = 0; return true;
    }
    __device__ __forceinline__ void a_ready(const Unit&) const {}
    __device__ __forceinline__ void done(const Unit&) const {}
};

__device__ __forceinline__ unsigned cvt_pk_bf16(float lo, float hi) { unsigned r; asm volatile("v_cvt_pk_bf16_f32 %0, %1, %2" : "=v"(r) : "v"(lo), "v"(hi)); return r; }
struct EpiStoreBf16 {
    static constexpr bool PERM = true, AFTER_DRAIN = false;
    bf16_t* O; int ldc;
    __device__ __forceinline__ void operator()(const f32x4 (&acc)[2][2][4][2], const Unit& u, int wr, int wc, int fr, int fq) const {
        const int row0 = u.pm * BM + wr * 64 + fr, col0 = u.pn * BM + wc * 32 + 8 * fq;
#pragma unroll
        for (int ai = 0; ai < 2; ++ai)
#pragma unroll
            for (int m = 0; m < 4; ++m) { bf16_t* rowp = O + (size_t)(row0 + ai * HALF + m * 16) * ldc + col0;
#pragma unroll
                for (int bj = 0; bj < 2; ++bj) { const f32x4 v0 = acc[ai][bj][m][0], v1 = acc[ai][bj][m][1];
                    u32x4 w; w.x = cvt_pk_bf16(v0[0], v0[1]); w.y = cvt_pk_bf16(v0[2], v0[3]); w.z = cvt_pk_bf16(v1[0], v1[1]); w.w = cvt_pk_bf16(v1[2], v1[3]);
                    *(u32x4*)(rowp + bj * HALF) = w; } }
    }
};
__device__ __forceinline__ float silu_mul(float g, float u) { return g * u * __builtin_amdgcn_rcpf(1.0f + __builtin_amdgcn_exp2f(-1.4426950408889634f * g)); }
struct EpiSwiGLU {
    static constexpr bool PERM = true, AFTER_DRAIN = false;
    bf16_t* H; int ldh;
    __device__ __forceinline__ void operator()(const f32x4 (&acc)[2][2][4][2], const Unit& u, int wr, int wc, int fr, int fq) const {
        const int row0 = u.pm * BM + wr * 64 + fr, col0 = u.pn * HALF + wc * 32 + 8 * fq;
#pragma unroll
        for (int ai = 0; ai < 2; ++ai)
#pragma unroll
            for (int m = 0; m < 4; ++m) { bf16_t* rowp = H + (size_t)(row0 + ai * HALF + m * 16) * ldh + col0;
                const f32x4 g0 = acc[ai][0][m][0], g1 = acc[ai][0][m][1], u0 = acc[ai][1][m][0], u1 = acc[ai][1][m][1];
                u32x4 w; w.x = cvt_pk_bf16(silu_mul(g0[0], u0[0]), silu_mul(g0[1], u0[1])); w.y = cvt_pk_bf16(silu_mul(g0[2], u0[2]), silu_mul(g0[3], u0[3]));
                w.z = cvt_pk_bf16(silu_mul(g1[0], u1[0]), silu_mul(g1[1], u1[1])); w.w = cvt_pk_bf16(silu_mul(g1[2], u1[2]), silu_mul(g1[3], u1[3]));
                *(u32x4*)rowp = w; }
    }
};
struct EpiF32 {
    static constexpr bool PERM = false, AFTER_DRAIN = false;
    float* O; int ldc; const float* R; float alpha;
    __device__ __forceinline__ void operator()(const f32x4 (&acc)[2][2][4][2], const Unit& u, int wr, int wc, int fr, int fq) const {
        const int row0 = u.pm * BM + wr * 64 + fr, col0 = u.pn * BM + wc * 32 + 4 * fq;
#pragma unroll
        for (int ai = 0; ai < 2; ++ai)
#pragma unroll
            for (int m = 0; m < 4; ++m) { const size_t off = (size_t)(row0 + ai * HALF + m * 16) * ldc + col0;
#pragma unroll
                for (int bj = 0; bj < 2; ++bj)
#pragma unroll
                    for (int n = 0; n < 2; ++n) { f32x4 v = acc[ai][bj][m][n]; if (R) v += alpha * *(const f32x4*)(R + off + bj * HALF + n * 16); *(f32x4*)(O + off + bj * HALF + n * 16) = v; } }
    }
};
struct MoeOrder {
    int nN, nunits, G, c; long estride; int pb[9];
    __device__ __forceinline__ void init(const int* pblk, int nN_, long estride_, int G_, int c_) { nN = nN_; G = G_; c = c_; estride = estride_;
#pragma unroll
        for (int e = 0; e < 9; ++e) pb[e] = __builtin_amdgcn_readfirstlane(pblk[e]);
        nunits = pb[8] * nN; }
    __device__ __forceinline__ bool next(int i, Unit& u) const {
        const int L = i * G + c; if (L >= nunits) return false;
        u.pm = L / nN; u.pn = L - u.pm * nN; int e = 0;
#pragma unroll
        for (int k = 1; k < 8; ++k) e += (u.pm >= pb[k]) ? 1 : 0;
        u.boff = (long)e * estride; return true; }
    __device__ __forceinline__ void a_ready(const Unit&) const {}
    __device__ __forceinline__ void done(const Unit&) const {}
};
template <class Epi, class Sched, bool ALIGN_EPI = false, bool SP2 = false>
__device__ __forceinline__ void gemm_phase(PG8_LAS unsigned char* lds, const Gemm g, const Sched& S, const Epi& E) {
    int tid_ = threadIdx.x; asm volatile("" : "+v"(tid_));
    const int tid = tid_, wid = __builtin_amdgcn_readfirstlane(tid >> 6), lane = tid & 63, wr = wid >> 2, wc = wid & 3, fr = lane & 15, fq = lane >> 4;
    const int K = g.K, nt = K / BK;
    unsigned voffA[2], voffB[2];
#pragma unroll
    for (int i = 0; i < 2; ++i) { int R, C; stage_rc(tid * 16 + i * 8192, R, C); const int Rb = Epi::PERM ? ((R & ~31) + perm32(R & 31)) : R;
        voffA[i] = (unsigned)(R * K + C) * 2u; voffB[i] = (unsigned)(Rb * K + C) * 2u; }
    const size_t kstep = (size_t)(BK * 2);
    const size_t hstep = (size_t)HALF * K * 2;
    const size_t tstep = 2 * hstep;
    const unsigned ldsw = (unsigned)wid * 1024u;
    const int aoff = lds_byte(wr * 64 + fr, fq * 8), boff = lds_byte(wc * 32 + fr, fq * 8);
#define PG8_SA(b, h) (((b) * 2 + (h)) * HTB)
#define PG8_SB(b, h) ((4 + (b) * 2 + (h)) * HTB)
#define PG8_STAGE(bufoff, gbase, voff) do { _Pragma("unroll") for (int _i = 0; _i < 2; ++_i) \
        __builtin_amdgcn_global_load_lds((const unsigned*)((const char*)(gbase) + (voff)[_i]), (PG8_LAS unsigned*)(lds + (bufoff) + ldsw + _i * 8192), 16, 0, 0); } while (0)
#define PG8_LDA(dst, b, h) do { _Pragma("unroll") for (int m = 0; m < 4; ++m) _Pragma("unroll") for (int k = 0; k < 2; ++k) dst[m][k] = *(const PG8_LAS bf16x8*)(lds + PG8_SA(b, h) + aoff + m * 2048 + k * 1024); } while (0)
#define PG8_LDB(dst, b, h) do { _Pragma("unroll") for (int n = 0; n < 2; ++n) _Pragma("unroll") for (int k = 0; k < 2; ++k) dst[n][k] = *(const PG8_LAS bf16x8*)(lds + PG8_SB(b, h) + boff + n * 2048 + k * 1024); } while (0)
#define PG8_MMA(ai, bj, At, Bt) do { __builtin_amdgcn_s_setprio(1); _Pragma("unroll") for (int m = 0; m < 4; ++m) _Pragma("unroll") for (int n = 0; n < 2; ++n) _Pragma("unroll") for (int k = 0; k < 2; ++k) \
        acc[ai][bj][m][n] = __builtin_amdgcn_mfma_f32_16x16x32_bf16(Bt[n][k], At[m][k], acc[ai][bj][m][n], 0, 0, 0); __builtin_amdgcn_s_setprio(0); } while (0)
#define PG8_WAIT_V(n) asm volatile("s_waitcnt vmcnt(" #n ")" ::: "memory")
#define PG8_WAIT_L(n) asm volatile("s_waitcnt lgkmcnt(" #n ")" ::: "memory")
#define PG8_BAR __builtin_amdgcn_s_barrier()
#define PG8_SCHED __builtin_amdgcn_sched_barrier(0)
    Unit cur, nxt; int ui = 0;
    if (!S.next(0, cur)) return;
    f32x4 acc[2][2][4][2];
#pragma unroll
    for (int a = 0; a < 2; ++a)
#pragma unroll
        for (int b = 0; b < 2; ++b)
#pragma unroll
            for (int m = 0; m < 4; ++m)
#pragma unroll
                for (int n = 0; n < 2; ++n) acc[a][b][m][n] = (f32x4){0.f, 0.f, 0.f, 0.f};
    bf16x8 At[4][2], B0[2][2], B1[2][2];
    const char* cA = (const char*)g.A + (size_t)cur.pm * tstep; const char* cB = (const char*)g.Bt + cur.boff + (size_t)cur.pn * tstep;
    S.a_ready(cur);
    if constexpr (SP2) {
        PG8_STAGE(PG8_SB(0, 0), cB, voffB); PG8_STAGE(PG8_SB(0, 1), cB + hstep, voffB); PG8_STAGE(PG8_SA(0, 0), cA, voffA); PG8_STAGE(PG8_SA(0, 1), cA + hstep, voffA);
        if (wr == 1) PG8_BAR;
        PG8_WAIT_V(2); PG8_BAR;
        PG8_STAGE(PG8_SB(1, 0), cB + kstep, voffB); PG8_STAGE(PG8_SA(1, 0), cA + kstep, voffA); PG8_STAGE(PG8_SB(1, 1), cB + hstep + kstep, voffB);
        PG8_WAIT_V(6); PG8_BAR;
    } else {
        PG8_STAGE(PG8_SB(0, 0), cB, voffB); PG8_STAGE(PG8_SA(0, 0), cA, voffA); PG8_STAGE(PG8_SB(0, 1), cB + hstep, voffB); PG8_STAGE(PG8_SA(0, 1), cA + hstep, voffA);
        if (wr == 1) PG8_BAR;
        PG8_WAIT_V(4); PG8_BAR;
        PG8_STAGE(PG8_SB(1, 0), cB + kstep, voffB); PG8_STAGE(PG8_SA(1, 0), cA + kstep, voffA); PG8_STAGE(PG8_SB(1, 1), cB + hstep + kstep, voffB);
        PG8_WAIT_V(6); PG8_BAR;
    }
    for (;;) {
        const bool has_next = S.next(ui + 1, nxt);
        const char* nA = has_next ? (const char*)g.A + (size_t)nxt.pm * tstep : cA; const char* nB = has_next ? (const char*)g.Bt + nxt.boff + (size_t)nxt.pn * tstep : cB;
        for (int t = 0; t < nt; t += 2) {
            const bool last = (t == nt - 2);
            const char* a1 = cA + (size_t)(t + 1) * kstep;
            const char* a2 = last ? nA : cA + (size_t)(t + 2) * kstep; const char* b2 = last ? nB : cB + (size_t)(t + 2) * kstep;
            const char* a3 = a2 + kstep; const char* b3 = b2 + kstep;
            if (last && has_next) S.a_ready(nxt);
            if constexpr (SP2) {
            PG8_LDB(B0, 0, 0); PG8_LDB(B1, 0, 1); PG8_SCHED; PG8_LDA(At, 0, 0); PG8_STAGE(PG8_SA(1, 1), a1 + hstep, voffA);
            PG8_WAIT_V(8); PG8_WAIT_L(0); PG8_BAR; PG8_MMA(0, 0, At, B0); PG8_MMA(0, 1, At, B1); PG8_BAR; PG8_SCHED;
            PG8_LDA(At, 0, 1); PG8_STAGE(PG8_SB(0, 0), b2, voffB); PG8_STAGE(PG8_SB(0, 1), b2 + hstep, voffB); PG8_STAGE(PG8_SA(0, 0), a2, voffA);
            PG8_WAIT_V(8); PG8_WAIT_L(0); PG8_BAR; PG8_MMA(1, 0, At, B0); PG8_MMA(1, 1, At, B1); PG8_BAR; PG8_SCHED;
            PG8_LDB(B0, 1, 0); PG8_LDB(B1, 1, 1); PG8_SCHED; PG8_LDA(At, 1, 0); PG8_STAGE(PG8_SA(0, 1), a2 + hstep, voffA);
            PG8_WAIT_V(8); PG8_WAIT_L(0); PG8_BAR; PG8_MMA(0, 0, At, B0); PG8_MMA(0, 1, At, B1); PG8_BAR; PG8_SCHED;
            PG8_LDA(At, 1, 1); PG8_STAGE(PG8_SB(1, 0), b3, voffB); PG8_STAGE(PG8_SB(1, 1), b3 + hstep, voffB); PG8_STAGE(PG8_SA(1, 0), a3, voffA);
            PG8_WAIT_V(8); PG8_WAIT_L(0); PG8_BAR; PG8_MMA(1, 0, At, B0); PG8_MMA(1, 1, At, B1); PG8_BAR; PG8_SCHED;
            } else {
            PG8_LDB(B0, 0, 0); PG8_SCHED; PG8_LDA(At, 0, 0); PG8_STAGE(PG8_SA(1, 1), a1 + hstep, voffA);
            PG8_WAIT_L(8); PG8_BAR; PG8_WAIT_L(0); PG8_MMA(0, 0, At, B0); PG8_BAR; PG8_SCHED;
            PG8_LDB(B1, 0, 1); PG8_STAGE(PG8_SB(0, 0), b2, voffB);
            PG8_BAR; PG8_WAIT_L(0); PG8_MMA(0, 1, At, B1); PG8_BAR;
            PG8_LDA(At, 0, 1); PG8_STAGE(PG8_SA(0, 0), a2, voffA);
            PG8_BAR; PG8_WAIT_L(0); PG8_MMA(1, 0, At, B0); PG8_BAR; PG8_SCHED;
            PG8_STAGE(PG8_SB(0, 1), b2 + hstep, voffB);
            PG8_WAIT_V(6); PG8_BAR; PG8_MMA(1, 1, At, B1); PG8_BAR;
            PG8_LDB(B0, 1, 0); PG8_SCHED; PG8_LDA(At, 1, 0); PG8_STAGE(PG8_SA(0, 1), a2 + hstep, voffA);
            PG8_WAIT_L(8); PG8_BAR; PG8_WAIT_L(0); PG8_MMA(0, 0, At, B0); PG8_BAR; PG8_SCHED;
            PG8_LDB(B1, 1, 1); PG8_STAGE(PG8_SB(1, 0), b3, voffB);
            PG8_BAR; PG8_WAIT_L(0); PG8_MMA(0, 1, At, B1); PG8_BAR;
            PG8_LDA(At, 1, 1); PG8_STAGE(PG8_SA(1, 0), a3, voffA);
            PG8_BAR; PG8_WAIT_L(0); PG8_MMA(1, 0, At, B0); PG8_BAR; PG8_SCHED;
            PG8_STAGE(PG8_SB(1, 1), b3 + hstep, voffB);
            PG8_WAIT_V(6); PG8_BAR; PG8_MMA(1, 1, At, B1); PG8_BAR;
            }
        }
        if constexpr (ALIGN_EPI) { if (wr == 0) PG8_BAR; }
        if constexpr (!Epi::AFTER_DRAIN) { E(acc, cur, wr, wc, fr, fq); S.done(cur); }
        if (!has_next) break;
#pragma unroll
        for (int a = 0; a < 2; ++a)
#pragma unroll
            for (int b = 0; b < 2; ++b)
#pragma unroll
                for (int m = 0; m < 4; ++m)
#pragma unroll
                    for (int n = 0; n < 2; ++n) acc[a][b][m][n] = (f32x4){0.f, 0.f, 0.f, 0.f};
        cur = nxt; cA = nA; cB = nB; ++ui;
        if constexpr (ALIGN_EPI) { if (wr == 1) PG8_BAR; }
    }
    PG8_WAIT_V(0);
    if constexpr (!ALIGN_EPI) { if (wr == 0) PG8_BAR; }
    PG8_BAR;
    if constexpr (Epi::AFTER_DRAIN) { E.fused(acc, cur, wr, wc, fr, fq, lds, wid, lane); S.done(cur); }
#undef PG8_SA
#undef PG8_SB
#undef PG8_STAGE
#undef PG8_LDA
#undef PG8_LDB
#undef PG8_MMA
#undef PG8_WAIT_V
#undef PG8_WAIT_L
#undef PG8_BAR
#undef PG8_SCHED
}
}

#define DI __device__ __forceinline__
#define LAS __attribute__((address_space(3)))
typedef unsigned short bf16;
typedef unsigned u32x4 __attribute__((ext_vector_type(4)));
typedef unsigned u32x2 __attribute__((ext_vector_type(2)));
typedef float f32x4 __attribute__((ext_vector_type(4)));
typedef float f32x2 __attribute__((ext_vector_type(2)));
typedef float f32x16 __attribute__((ext_vector_type(16)));
typedef short bf16x8 __attribute__((ext_vector_type(8)));
typedef short s16x4 __attribute__((ext_vector_type(4)));
typedef unsigned gu32;

constexpr int NB = 8, SEQ = 2048, DM = 1024, NTOK = NB * SEQ;
constexpr int EV_N = 2472, EV_NP = 2560, OD_N = 3072;
constexpr int FF = 2816, FFE = 3584, NEXP = 8;
constexpr int C_QA = 0, C_KA = 512, C_VA = 576, C_IQ = 640, C_IK = 896, C_IW = 928, C_QB = 936, C_KB = 1448, C_VB = 1960;
constexpr int OC_Q = 0, OC_K = 1024, OC_V = 2048;
constexpr float ALPHA = 1.6817928305074290f;
constexpr float LN_EPS = 1e-5f;
constexpr float QSCALE = 0.125f * 1.4426950408889634f;
constexpr int MOE_ROWS = 2 * NTOK + NEXP * 256;
constexpr int NWAVES = 8, NTHR = 512;

constexpr size_t MiB = 1u << 20;
constexpr size_t WS_CTL = 0, CTL_ZERO_BYTES = 1 * MiB;
constexpr size_t WS_TAB = 1 * MiB;
constexpr size_t WS_MISC = 2 * MiB;
constexpr size_t WS_MASK = 6 * MiB;
constexpr size_t WS_WIN = 10 * MiB, WS_WOUT = 18 * MiB, WS_WUP = 20 * MiB, WS_WDN = 132 * MiB;
constexpr size_t WS_XF = 188 * MiB, WS_XB = 252 * MiB;
constexpr size_t WS_R1 = 284 * MiB;
constexpr size_t WS_O = WS_R1 + 96 * MiB;
constexpr size_t WS_MIX = 524 * MiB;
constexpr size_t WS_XBUF = 660 * MiB;
constexpr size_t WS_END = 728 * MiB;
constexpr size_t MS_EID = 0, MS_GATE = 128 * 1024, MS_ROWOF = 256 * 1024, MS_TOKOF = 384 * 1024, MS_KM = 640 * 1024, MS_PBLK = 768 * 1024, MS_LSE3 = 1 * MiB;
constexpr size_t TB_COS64 = 0, TB_SIN64 = 256 * 1024, TB_COS32 = 512 * 1024, TB_SIN32 = 640 * 1024;
constexpr int CW_TMO = 0, CW_BAR = 4096;

constexpr int LDS_BYTES = 152 * 1024;

DI unsigned f2bf(float f) { unsigned u = __builtin_bit_cast(unsigned, f); return (u + 0x7fffu + ((u >> 16) & 1u)) >> 16; }
DI unsigned pk2(float lo, float hi) { return f2bf(lo) | (f2bf(hi) << 16); }
DI float bf2f(unsigned short h) { return __builtin_bit_cast(float, (unsigned)h << 16); }
DI float bflo(unsigned w) { return __builtin_bit_cast(float, w << 16); }
DI float bfhi(unsigned w) { return __builtin_bit_cast(float, w & 0xffff0000u); }
DI float wave_sum(float v) {
#pragma unroll
    for (int o = 1; o < 64; o <<= 1) v += __shfl_xor(v, o);
    return v;
}
#define LDS_WAIT() asm volatile("s_waitcnt lgkmcnt(0)" ::: "memory")
#define XB_TMO      128
#define XB_XCNT(j)  (256  + 64 * (j))
#define XB_XSUB(j)  (1280 + 64 * (j))
#define XB_XGEN(j)  (2304 + 64 * (j))
#define XB_TOP      3328
#define XB_TOPGEN   3392
#define XCD_BAR_WORDS 3456
#define XB_SPIN_CAP (1u << 18)

__device__ __forceinline__ unsigned xb_ld(unsigned* p)              { return __hip_atomic_load(p, __ATOMIC_RELAXED, __HIP_MEMORY_SCOPE_AGENT); }
__device__ __forceinline__ unsigned xb_add(unsigned* p, unsigned v) { return __hip_atomic_fetch_add(p, v, __ATOMIC_RELAXED, __HIP_MEMORY_SCOPE_AGENT); }
__device__ __forceinline__ unsigned xb_xcc_id() { return (unsigned)__builtin_amdgcn_s_getreg((3 << 11) | 20) & 0xFu; }
#define XB_SPIN(cond, bar) do { unsigned _sp = 0; while (cond) { __builtin_amdgcn_s_sleep(1); \
    if ((++_sp & 255u) == 0u) { if (xb_ld(&(bar)[XB_TMO])) break; if (_sp > XB_SPIN_CAP) { atomicAdd(&(bar)[XB_TMO], 1u); break; } } } } while (0)

struct XcdBarrier {
    unsigned* bar; unsigned x;
    volatile LAS unsigned* st;
};

__device__ __forceinline__ XcdBarrier xcd_barrier_post(unsigned* bar, volatile LAS unsigned* st) {
    XcdBarrier b; b.bar = bar; b.x = xb_xcc_id(); b.st = st;
    if (threadIdx.x == 0) (void)xb_add(&bar[XB_XCNT(b.x)], 1u);
    return b;
}
__device__ __forceinline__ void xcd_barrier_complete(unsigned* bar, unsigned x, unsigned& nloc, unsigned& nx) {
    const unsigned G = gridDim.x * gridDim.y * gridDim.z;
    unsigned sum, cnt, mine, sp = 0u;
    for (;;) {
        sum = 0u; cnt = 0u; mine = 0u;
#pragma unroll
        for (unsigned j = 0; j < 16; ++j) { const unsigned c = xb_ld(&bar[XB_XCNT(j)]); sum += c; cnt += (c > 0u) ? 1u : 0u; mine = (j == x) ? c : mine; }
        if (sum == G) break;
        __builtin_amdgcn_s_sleep(1);
        if ((++sp & 255u) == 0u) { if (xb_ld(&bar[XB_TMO])) break; if (sp > XB_SPIN_CAP) { atomicAdd(&bar[XB_TMO], 1u); break; } }
    }
    nloc = mine > 0u ? mine : 1u; nx = cnt > 0u ? cnt : 1u;
}

__device__ __forceinline__ void xcd_barrier(const XcdBarrier& b) {
    asm volatile("s_waitcnt vmcnt(0)" ::: "memory");
    __syncthreads();
    if (threadIdx.x == 0) {
        unsigned* bar = b.bar;
        __builtin_amdgcn_s_waitcnt(0);
        unsigned nloc = b.st[0], nx = b.st[1];
        if (nloc == 0u) { xcd_barrier_complete(bar, b.x, nloc, nx); b.st[0] = nloc; b.st[1] = nx; }
        const unsigned old = xb_add(&bar[XB_XSUB(b.x)], 1u);
        const unsigned gen = old / nloc;
        if (old + 1u == (gen + 1u) * nloc) {
            __builtin_amdgcn_fence(__ATOMIC_RELEASE, "agent");
            asm volatile("s_waitcnt vmcnt(0)" ::: "memory");
            const unsigned og = xb_add(&bar[XB_TOP], 1u);
            const unsigned tg = og / nx;
            if (og + 1u == (tg + 1u) * nx) xb_add(&bar[XB_TOPGEN], 1u);
            else XB_SPIN(xb_ld(&bar[XB_TOPGEN]) == tg, bar);
            __builtin_amdgcn_fence(__ATOMIC_ACQUIRE, "agent");
            xb_add(&bar[XB_XGEN(b.x)], 1u);
            asm volatile("s_waitcnt vmcnt(0)" ::: "memory");
        } else {
            XB_SPIN(xb_ld(&bar[XB_XGEN(b.x)]) == gen, bar);
            __builtin_amdgcn_fence(__ATOMIC_ACQUIRE, "agent");
            asm volatile("s_waitcnt vmcnt(0)" ::: "memory");
        }
    }
    __syncthreads();
}

DI void tr_item(const float* W, int ldw, int nvalid, int k0, int n0, bf16* WT, int K, int drow0, LAS float* scr, int lane) {
    const int nn = n0 + (lane & 31); const bool ok = nn < nvalid;
#pragma unroll 8
    for (int i = 0; i < 32; ++i) { const int kk = 2 * i + (lane >> 5); scr[kk * 33 + (lane & 31)] = ok ? W[(size_t)(k0 + kk) * ldw + nn] : 0.f; }
    LDS_WAIT(); asm volatile("" ::: "memory");
    const int c = lane & 7;
#pragma unroll
    for (int j = 0; j < 4; ++j) { const int n = (lane >> 3) + 8 * j; const LAS float* s = scr + (8 * c) * 33 + n;
        u32x4 o; o.x = pk2(s[0 * 33], s[1 * 33]); o.y = pk2(s[2 * 33], s[3 * 33]); o.z = pk2(s[4 * 33], s[5 * 33]); o.w = pk2(s[6 * 33], s[7 * 33]);
        *(u32x4*)(WT + (size_t)(drow0 + n) * K + k0 + 8 * c) = o; }
    LDS_WAIT(); asm volatile("" ::: "memory");
}
DI void tr_plain(const float* W, int K, int N, int Npad, bf16* WT, LAS float* scr, int r, int lane) {
    const int nblk = Npad / 32, kb = r / nblk, nb = r % nblk;
    tr_item(W, N, N, 64 * kb, 32 * nb, WT, K, 32 * nb, scr, lane);
}
DI void tr_gu(const float* W, int K, int N, int half, bf16* WT, LAS float* scr, int r, int lane) {
    const int nblk = N / 32, kb = r / nblk, nb = r % nblk, n0 = 32 * nb;
    tr_item(W, N, N, 64 * kb, n0, WT, K, (n0 >> 7) * 256 + (n0 & 127) + half * 128, scr, lane);
}
struct Ptrs {
    const float* in[20]; float* out; unsigned char* ws;
    int tid, lane, wave, bid, G;
};
DI void phase_convert_even(const Ptrs& P, LAS unsigned char* lds, int li) {
    LAS float* scr = (LAS float*)(lds + P.wave * 16384);
    const int gw = P.bid * NWAVES + P.wave, NGW = P.G * NWAVES;
    const float* w_in = P.in[1] + (size_t)li * DM * EV_N; const float* w_out = P.in[2] + (size_t)li * DM * DM;
    const float* w1 = P.in[5] + (size_t)li * DM * FF; const float* w3 = P.in[6] + (size_t)li * DM * FF; const float* w2 = P.in[7] + (size_t)li * FF * DM;
    bf16* WIN = (bf16*)(P.ws + WS_WIN); bf16* WOUT = (bf16*)(P.ws + WS_WOUT); bf16* WUP = (bf16*)(P.ws + WS_WUP); bf16* WDN = (bf16*)(P.ws + WS_WDN);
    constexpr int I_IN = (DM / 64) * (EV_NP / 32), I_OUT = (DM / 64) * (DM / 32), I_GU = (DM / 64) * (FF / 32), I_DN = (FF / 64) * (DM / 32);
    constexpr int NIT = I_IN + I_OUT + 2 * I_GU + I_DN;
    for (int it = gw; it < NIT; it += NGW) {
        int r = it;
        if (r < I_IN) { tr_plain(w_in, DM, EV_N, EV_NP, WIN, scr, r, P.lane); continue; } r -= I_IN;
        if (r < I_OUT) { tr_plain(w_out, DM, DM, DM, WOUT, scr, r, P.lane); continue; } r -= I_OUT;
        if (r < I_GU) { tr_gu(w1, DM, FF, 0, WUP, scr, r, P.lane); continue; } r -= I_GU;
        if (r < I_GU) { tr_gu(w3, DM, FF, 1, WUP, scr, r, P.lane); continue; } r -= I_GU;
        tr_plain(w2, FF, DM, DM, WDN, scr, r, P.lane);
    }
}
DI void phase_convert_odd(const Ptrs& P, LAS unsigned char* lds, int li) {
    LAS float* scr = (LAS float*)(lds + P.wave * 16384);
    const int gw = P.bid * NWAVES + P.wave, NGW = P.G * NWAVES;
    const float* w_in = P.in[10] + (size_t)li * DM * OD_N; const float* w_out = P.in[11] + (size_t)li * DM * DM;
    const float* w1 = P.in[15] + (size_t)li * NEXP * DM * FFE; const float* w3 = P.in[16] + (size_t)li * NEXP * DM * FFE; const float* w2 = P.in[17] + (size_t)li * NEXP * FFE * DM;
    bf16* WIN = (bf16*)(P.ws + WS_WIN); bf16* WOUT = (bf16*)(P.ws + WS_WOUT); bf16* WUP = (bf16*)(P.ws + WS_WUP); bf16* WDN = (bf16*)(P.ws + WS_WDN);
    constexpr int I_IN = (DM / 64) * (OD_N / 32), I_OUT = (DM / 64) * (DM / 32), I_GU = (DM / 64) * (FFE / 32), I_DN = (FFE / 64) * (DM / 32);
    constexpr int NIT = I_IN + I_OUT + NEXP * (2 * I_GU + I_DN);
    for (int it = gw; it < NIT; it += NGW) {
        int r = it;
        if (r < I_IN) { tr_plain(w_in, DM, OD_N, OD_N, WIN, scr, r, P.lane); continue; } r -= I_IN;
        if (r < I_OUT) { tr_plain(w_out, DM, DM, DM, WOUT, scr, r, P.lane); continue; } r -= I_OUT;
        const int e = r / (2 * I_GU + I_DN); r -= e * (2 * I_GU + I_DN);
        if (r < I_GU) { tr_gu(w1 + (size_t)e * DM * FFE, DM, FFE, 0, WUP + (size_t)e * 2 * FFE * DM, scr, r, P.lane); continue; } r -= I_GU;
        if (r < I_GU) { tr_gu(w3 + (size_t)e * DM * FFE, DM, FFE, 1, WUP + (size_t)e * 2 * FFE * DM, scr, r, P.lane); continue; } r -= I_GU;
        tr_plain(w2 + (size_t)e * FFE * DM, FFE, DM, DM, WDN + (size_t)e * DM * FFE, scr, r, P.lane);
    }
}
DI void phase_init(const Ptrs& P) {
    const int gw = P.bid * NWAVES + P.wave, NGW = P.G * NWAVES;
    const float* x = P.in[0]; bf16* XB = (bf16*)(P.ws + WS_XB);
    for (int m = gw; m < NTOK; m += NGW) {
        const f32x4* xr = (const f32x4*)(x + (size_t)m * DM) + P.lane; u32x2* o = (u32x2*)(XB + (size_t)m * DM) + P.lane;
#pragma unroll
        for (int j = 0; j < 4; ++j) { const f32x4 v = xr[64 * j]; u32x2 w; w.x = pk2(v.x, v.y); w.y = pk2(v.z, v.w); o[64 * j] = w; }
    }
    float* c64 = (float*)(P.ws + WS_TAB + TB_COS64); float* s64 = (float*)(P.ws + WS_TAB + TB_SIN64);
    float* c32 = (float*)(P.ws + WS_TAB + TB_COS32); float* s32 = (float*)(P.ws + WS_TAB + TB_SIN32);
    const int gt = P.bid * NTHR + P.tid, NGT = P.G * NTHR;
    for (int i = gt; i < SEQ * 32; i += NGT) { const int pos = i >> 5, j = i & 31; const float inv = exp2f(-(float)j * (13.287712379549449f / 32.0f)); const float a = (float)pos * inv; const double rv = (double)a * 0.15915494309189535; const float fr = (float)(rv - floor(rv)); c64[i] = __builtin_amdgcn_cosf(fr); s64[i] = __builtin_amdgcn_sinf(fr); }
    for (int i = gt; i < SEQ * 16; i += NGT) { const int pos = i >> 4, j = i & 15; const float inv = exp2f(-(float)j * (13.287712379549449f / 16.0f)); const float a = (float)pos * inv; const double rv = (double)a * 0.15915494309189535; const float fr = (float)(rv - floor(rv)); c32[i] = __builtin_amdgcn_cosf(fr); s32[i] = __builtin_amdgcn_sinf(fr); }
}

DI void rope_item(bf16* p, int half, float scale, const float* ct, const float* st) {
    const u32x2 a = *(const u32x2*)p, b = *(const u32x2*)(p + half);
    const f32x4 c = *(const f32x4*)ct, s = *(const f32x4*)st;
    const f32x4 x1 = {bflo(a.x), bfhi(a.x), bflo(a.y), bfhi(a.y)}, x2 = {bflo(b.x), bfhi(b.x), bflo(b.y), bfhi(b.y)};
    const f32x4 o1 = (x1 * c - x2 * s) * scale, o2 = (x1 * s + x2 * c) * scale;
    u32x2 wa, wb; wa.x = pk2(o1.x, o1.y); wa.y = pk2(o1.z, o1.w); wb.x = pk2(o2.x, o2.y); wb.y = pk2(o2.z, o2.w);
    *(u32x2*)p = wa; *(u32x2*)(p + half) = wb;
}
DI void phase_rope_even(const Ptrs& P) {
    const int gw = P.bid * NWAVES + P.wave, NGW = P.G * NWAVES;
    bf16* PROJ = (bf16*)(P.ws + WS_R1);
    const float* c64 = (const float*)(P.ws + WS_TAB + TB_COS64); const float* s64 = (const float*)(P.ws + WS_TAB + TB_SIN64);
    const float* c32 = (const float*)(P.ws + WS_TAB + TB_COS32); const float* s32 = (const float*)(P.ws + WS_TAB + TB_SIN32);
    for (int m = gw; m < NTOK; m += NGW) {
        const int pos = m & (SEQ - 1); bf16* row = PROJ + (size_t)m * EV_NP;
        for (int id = P.lane; id < 236; id += 64) {
            int col, jj, half = 32; float sc = 1.f;
            if (id < 64) { col = C_QA + (id >> 3) * 64; jj = (id & 7) * 4; sc = QSCALE; }
            else if (id < 72) { col = C_KA; jj = (id - 64) * 4; }
            else if (id < 104) { const int k = id - 72; col = C_IQ + (k >> 2) * 32; jj = (k & 3) * 4; half = 16; }
            else if (id < 108) { col = C_IK; jj = (id - 104) * 4; half = 16; }
            else if (id < 172) { const int k = id - 108; col = C_QB + (k >> 3) * 64; jj = (k & 7) * 4; sc = QSCALE; }
            else { const int k = id - 172; col = C_KB + (k >> 3) * 64; jj = (k & 7) * 4; }
            const float* ct = (half == 32) ? c64 + pos * 32 + jj : c32 + pos * 16 + jj;
            const float* st = (half == 32) ? s64 + pos * 32 + jj : s32 + pos * 16 + jj;
            rope_item(row + col + jj, half, sc, ct, st);
        }
    }
}
DI void phase_rope_odd(const Ptrs& P) {
    const int gw = P.bid * NWAVES + P.wave, NGW = P.G * NWAVES;
    bf16* PROJ = (bf16*)(P.ws + WS_R1);
    const float* c64 = (const float*)(P.ws + WS_TAB + TB_COS64); const float* s64 = (const float*)(P.ws + WS_TAB + TB_SIN64);
    for (int m = gw; m < NTOK; m += NGW) {
        const int pos = m & (SEQ - 1); bf16* row = PROJ + (size_t)m * OD_N;
#pragma unroll
        for (int r = 0; r < 4; ++r) { const int id = P.lane + 64 * r;
            const int k = id & 127, col = (id < 128 ? OC_Q : OC_K) + (k >> 3) * 64, jj = (k & 7) * 4;
            rope_item(row + col + jj, 32, id < 128 ? QSCALE : 1.f, c64 + pos * 32 + jj, s64 + pos * 32 + jj); }
    }
}

DI void ln_core(f32x4 (&v)[4], const float* g, const float* b, int lane) {
    float s = 0.f;
#pragma unroll
    for (int j = 0; j < 4; ++j) s += (v[j].x + v[j].y) + (v[j].z + v[j].w);
    const float mean = wave_sum(s) * (1.f / DM); float s2 = 0.f;
#pragma unroll
    for (int j = 0; j < 4; ++j) { v[j] = v[j] - mean; s2 += (v[j].x * v[j].x + v[j].y * v[j].y) + (v[j].z * v[j].z + v[j].w * v[j].w); }
    const float rstd = 1.f / sqrtf(wave_sum(s2) * (1.f / DM) + LN_EPS);
#pragma unroll
    for (int j = 0; j < 4; ++j) { const f32x4 gg = ((const f32x4*)g)[64 * j + lane], bb = ((const f32x4*)b)[64 * j + lane]; v[j] = v[j] * rstd * gg + bb; }
}
DI void ln_store(const f32x4 (&v)[4], float* xf, bf16* xb, int lane) {
#pragma unroll
    for (int j = 0; j < 4; ++j) { ((f32x4*)xf)[64 * j + lane] = v[j]; if (xb) { u32x2 w; w.x = pk2(v[j].x, v[j].y); w.y = pk2(v[j].z, v[j].w); ((u32x2*)xb)[64 * j + lane] = w; } }
}
template <bool ROUTER> DI void phase_ln(const Ptrs& P, LAS unsigned char* lds, const float* g, const float* b, float* xf_out, bf16* xb_out, const float* router) {
    const int gw = P.bid * NWAVES + P.wave, NGW = P.G * NWAVES;
    const float* MIX = (const float*)(P.ws + WS_MIX);
    LAS float* rl = (LAS float*)lds;
    if (ROUTER) { for (int i = P.tid; i < DM * NEXP / 4; i += NTHR) ((LAS f32x4*)rl)[i] = ((const f32x4*)router)[i]; __syncthreads(); }
    int* eid = (int*)(P.ws + WS_MISC + MS_EID); float* gate = (float*)(P.ws + WS_MISC + MS_GATE);
    for (int m = gw; m < NTOK; m += NGW) {
        f32x4 v[4];
#pragma unroll
        for (int j = 0; j < 4; ++j) v[j] = ((const f32x4*)(MIX + (size_t)m * DM))[64 * j + P.lane];
        ln_core(v, g, b, P.lane);
        ln_store(v, xf_out + (size_t)m * DM, xb_out ? xb_out + (size_t)m * DM : nullptr, P.lane);
        if (ROUTER) {
            float lg[8];
#pragma unroll
            for (int e = 0; e < 8; ++e) lg[e] = 0.f;
#pragma unroll
            for (int j = 0; j < 4; ++j)
#pragma unroll
                for (int c = 0; c < 4; ++c) { const int col = 4 * (64 * j + P.lane) + c; const f32x4 r0 = *(const LAS f32x4*)(rl + col * 8), r1 = *(const LAS f32x4*)(rl + col * 8 + 4); const float x = v[j][c];
                    lg[0] += x * r0.x; lg[1] += x * r0.y; lg[2] += x * r0.z; lg[3] += x * r0.w; lg[4] += x * r1.x; lg[5] += x * r1.y; lg[6] += x * r1.z; lg[7] += x * r1.w; }
#pragma unroll
            for (int e = 0; e < 8; ++e) lg[e] = wave_sum(lg[e]);
            int i1 = 0; float v1 = lg[0];
#pragma unroll
            for (int e = 1; e < 8; ++e) if (lg[e] > v1) { v1 = lg[e]; i1 = e; }
            int i2 = -1; float v2 = -INFINITY;
#pragma unroll
            for (int e = 0; e < 8; ++e) if (e != i1 && lg[e] > v2) { v2 = lg[e]; i2 = e; }
            const float ex = expf(v2 - v1), g1 = 1.f / (1.f + ex), g2 = ex / (1.f + ex);
            if (P.lane == 0) { eid[2 * m] = i1; eid[2 * m + 1] = i2; gate[2 * m] = g1; gate[2 * m + 1] = g2; }
        }
    }
}

DI void phase_route(const Ptrs& P, LAS unsigned char* lds) {
    const int* eid = (const int*)(P.ws + WS_MISC + MS_EID);
    int* rowof = (int*)(P.ws + WS_MISC + MS_ROWOF); int* pblk = (int*)(P.ws + WS_MISC + MS_PBLK);
    const bf16* XB = (const bf16*)(P.ws + WS_XB); bf16* XBUF = (bf16*)(P.ws + WS_XBUF);
    LAS int* cl = (LAS int*)lds;
    for (int c = P.bid; c < NTOK / 64; c += P.G) {
        __syncthreads();
        if (P.tid < 32) cl[P.tid] = 0;
        __syncthreads();
        int tot[8], bef[8];
#pragma unroll
        for (int e = 0; e < 8; ++e) { tot[e] = 0; bef[e] = 0; }
        const int a0 = 128 * c;
        for (int k = 0; k < 64; ++k) { const int a = P.tid + NTHR * k; const int e = eid[a]; const int pre = (a < a0) ? 1 : 0;
#pragma unroll
            for (int x = 0; x < 8; ++x) { const int hit = (e == x) ? 1 : 0; tot[x] += hit; bef[x] += hit & pre; } }
#pragma unroll
        for (int x = 0; x < 8; ++x) {
            int t = tot[x], q = bef[x];
#pragma unroll
            for (int o = 1; o < 64; o <<= 1) { t += __shfl_xor(t, o); q += __shfl_xor(q, o); }
            if (P.lane == 0) { __hip_atomic_fetch_add(&cl[x], t, __ATOMIC_RELAXED, __HIP_MEMORY_SCOPE_WORKGROUP); __hip_atomic_fetch_add(&cl[8 + x], q, __ATOMIC_RELAXED, __HIP_MEMORY_SCOPE_WORKGROUP); }
        }
        __syncthreads();
        if (P.tid == 0) { int acc = 0; for (int e = 0; e < 8; ++e) { cl[16 + e] = acc; acc += (cl[e] + 255) >> 8; } cl[24] = acc; }
        __syncthreads();
        if (P.wave == 0) {
            int run[8];
#pragma unroll
            for (int x = 0; x < 8; ++x) run[x] = 0;
            const unsigned long long lt = (P.lane == 0) ? 0ull : (~0ull >> (64 - P.lane));
#pragma unroll
            for (int h = 0; h < 2; ++h) { const int i = 64 * h + P.lane; const int e = eid[a0 + i]; int dest = 0;
#pragma unroll
                for (int x = 0; x < 8; ++x) { const unsigned long long mk = __ballot(e == x); if (e == x) dest = 256 * cl[16 + x] + cl[8 + x] + run[x] + __builtin_popcountll(mk & lt); run[x] += __builtin_popcountll(mk); }
                cl[32 + i] = dest; rowof[a0 + i] = dest; }
        }
        if (c == 0 && P.tid < 9) pblk[P.tid] = cl[16 + P.tid];
        __syncthreads();
        for (int i = P.wave; i < 128; i += NWAVES) { const int dest = cl[32 + i]; const int t = (a0 + i) >> 1;
            const u32x4* s = (const u32x4*)(XB + (size_t)t * DM) + 2 * P.lane; u32x4* d = (u32x4*)(XBUF + (size_t)dest * DM) + 2 * P.lane;
            const u32x4 v0 = s[0], v1 = s[1]; d[0] = v0; d[1] = v1; }
    }
}
DI void phase_moe_combine(const Ptrs& P, const float* g, const float* b, float* xf_out, bf16* xb_out) {
    const int gw = P.bid * NWAVES + P.wave, NGW = P.G * NWAVES;
    const float* XF = (const float*)(P.ws + WS_XF); const float* Y = (const float*)(P.ws + WS_MIX);
    const int* rowof = (const int*)(P.ws + WS_MISC + MS_ROWOF); const float* gate = (const float*)(P.ws + WS_MISC + MS_GATE);
    for (int m = gw; m < NTOK; m += NGW) {
        const int r0 = rowof[2 * m], r1 = rowof[2 * m + 1]; const float g0 = gate[2 * m], g1 = gate[2 * m + 1];
        f32x4 v[4];
#pragma unroll
        for (int j = 0; j < 4; ++j) { const f32x4 x = ((const f32x4*)(XF + (size_t)m * DM))[64 * j + P.lane], y0 = ((const f32x4*)(Y + (size_t)r0 * DM))[64 * j + P.lane], y1 = ((const f32x4*)(Y + (size_t)r1 * DM))[64 * j + P.lane];
            v[j] = ALPHA * x + (g0 * y0 + g1 * y1); }
        ln_core(v, g, b, P.lane);
        ln_store(v, xf_out + (size_t)m * DM, xb_out ? xb_out + (size_t)m * DM : nullptr, P.lane);
    }
}

constexpr int SC_LD = 2052;
DI unsigned fkey(float f) { const unsigned u = __builtin_bit_cast(unsigned, f); return (u & 0x80000000u) ? ~u : (u | 0x80000000u); }
DI void idx_unit(const Ptrs& P, LAS unsigned char* lds, int b, int qb16) {
    const bf16* PROJ = (const bf16*)(P.ws + WS_R1); unsigned* MASK = (unsigned*)(P.ws + WS_MASK);
    LAS float* sc = (LAS float*)lds;
    const int t0 = 16 * qb16, lane = P.lane, l15 = lane & 15, l4 = lane >> 4; const size_t rowbase = (size_t)b * SEQ;
    __syncthreads();
    {
        const bf16* qrow = PROJ + (rowbase + t0 + l15) * EV_NP;
        bf16x8 bq[8];
#pragma unroll
        for (int h = 0; h < 8; ++h) bq[h] = *(const bf16x8*)(qrow + C_IQ + h * 32 + 8 * l4);
        const u32x4 wraw = *(const u32x4*)(qrow + C_IW); float wv[8];
        const float WS = 0.17677669529663687f * 0.35355339059327373f;
        wv[0] = bflo(wraw.x) * WS; wv[1] = bfhi(wraw.x) * WS; wv[2] = bflo(wraw.y) * WS; wv[3] = bfhi(wraw.y) * WS; wv[4] = bflo(wraw.z) * WS; wv[5] = bfhi(wraw.z) * WS; wv[6] = bflo(wraw.w) * WS; wv[7] = bfhi(wraw.w) * WS;
        const int nkt = qb16 + 1;
        for (int kt = P.wave; kt < nkt; kt += NWAVES) {
            const bf16x8 ak = *(const bf16x8*)(PROJ + (rowbase + 16 * kt + l15) * EV_NP + C_IK + 8 * l4);
            f32x4 s = {0.f, 0.f, 0.f, 0.f};
#pragma unroll
            for (int h = 0; h < 8; ++h) { const f32x4 z = {0.f, 0.f, 0.f, 0.f}; const f32x4 d = __builtin_amdgcn_mfma_f32_16x16x32_bf16(ak, bq[h], z, 0, 0, 0);
                s.x += wv[h] * fmaxf(d.x, 0.f); s.y += wv[h] * fmaxf(d.y, 0.f); s.z += wv[h] * fmaxf(d.z, 0.f); s.w += wv[h] * fmaxf(d.w, 0.f); }
            if (kt == nkt - 1) { const int kq = 4 * l4; if (kq + 0 > l15) s.x = -INFINITY; if (kq + 1 > l15) s.y = -INFINITY; if (kq + 2 > l15) s.z = -INFINITY; if (kq + 3 > l15) s.w = -INFINITY; }
            *(LAS f32x4*)(sc + l15 * SC_LD + 16 * kt + 4 * l4) = s;
        }
    }
    __syncthreads();
    const unsigned long long ltm = (lane == 0) ? 0ull : (~0ull >> (64 - lane));
    for (int rr = 0; rr < 2; ++rr) {
        const int r = 2 * P.wave + rr, t = t0 + r; const int jmax = (t >> 6) + 1;
        unsigned key[32];
#pragma unroll
        for (int j = 0; j < 32; ++j) { const int idx = 64 * j + lane; key[j] = 0u; if (j < jmax) { const float f = sc[r * SC_LD + idx]; key[j] = (idx <= t) ? fkey(f) : 0u; } }
        unsigned T = 0u; int need = 0;
        const bool all = (t + 1 <= 256);
        if (!all) {
            for (int bit = 31; bit >= 0; --bit) { const unsigned cand = T | (1u << bit); int cnt = 0;
#pragma unroll
                for (int j = 0; j < 32; ++j) if (j < jmax) cnt += __builtin_popcountll(__ballot(key[j] >= cand));
                if (cnt >= 256) T = cand; }
            int ngt = 0;
#pragma unroll
            for (int j = 0; j < 32; ++j) if (j < jmax) ngt += __builtin_popcountll(__ballot(key[j] > T));
            need = 256 - ngt;
        }
        unsigned myw = 0u; int run = 0;
#pragma unroll
        for (int j = 0; j < 32; ++j) {
            unsigned long long sm = 0ull;
            if (j < jmax) {
                if (all) sm = __ballot(key[j] != 0u);
                else { const bool eq = key[j] == T; const unsigned long long em = __ballot(eq); const int rank = run + __builtin_popcountll(em & ltm);
                       sm = __ballot(key[j] > T || (eq && rank < need)); run += __builtin_popcountll(em); }
            }
            if (lane == 2 * j) myw = (unsigned)sm;
            if (lane == 2 * j + 1) myw = (unsigned)(sm >> 32);
        }
        MASK[(rowbase + t) * 64 + lane] = myw;
    }
}
DI void kmean_unit(const Ptrs& P, int b, int n) {
    const bf16* PROJ = (const bf16*)(P.ws + WS_R1); bf16* KM = (bf16*)(P.ws + WS_MISC + MS_KM);
    const int col = P.tid; const bf16* p = PROJ + ((size_t)b * SEQ + 256 * n) * EV_NP + C_KB + col; float s = 0.f;
#pragma unroll 8
    for (int r = 0; r < 256; ++r) s += bf2f(p[(size_t)r * EV_NP]);
    KM[(((size_t)b * 8 + (col >> 6)) * 8 + n) * 64 + (col & 63)] = (bf16)f2bf(s * (1.f / 256.f));
}
DI void phase_index(const Ptrs& P, LAS unsigned char* lds) {
    for (int u = P.bid; u < 64; u += P.G) kmean_unit(P, u & 7, u >> 3);
    for (int k = 0; ; ++k) { const int u = P.bid + P.G * k; if (u >= 1024) break;
        const int b = u & 7, v = u >> 3, kq = v >> 5, a = v & 31; const int idx = (kq == 0) ? a : (kq == 1) ? 127 - a : (kq == 2) ? 32 + a : 95 - a;
        idx_unit(P, lds, b, idx); }
}

constexpr int KROW = 144;
constexpr float M_INIT = -1.0e30f;
DI f32x16 mfma32(bf16x8 a, bf16x8 b, f32x16 c) { return __builtin_amdgcn_mfma_f32_32x32x16_bf16(a, b, c, 0, 0, 0); }
typedef short v4i16_t __attribute__((ext_vector_type(4)));
DI s16x4 vtr(const LAS unsigned char* p) { return __builtin_bit_cast(s16x4, __builtin_amdgcn_ds_read_tr16_b64_v4i16((LAS v4i16_t*)p)); }
typedef __bf16 bf16x2_t __attribute__((ext_vector_type(2)));
DI unsigned cvtpk(float lo, float hi) { const f32x2 v = {lo, hi}; const bf16x2_t b = __builtin_convertvector(v, bf16x2_t); return __builtin_bit_cast(unsigned, b); }
DI void swap32(unsigned& a, unsigned& b) { asm volatile("s_nop 1\n\tv_permlane32_swap_b32 %0, %1\n\ts_nop 1" : "+v"(a), "+v"(b)); }
DI float xhalf_max(float m) { unsigned a = __builtin_bit_cast(unsigned, m), b = a; swap32(a, b); return fmaxf(__builtin_bit_cast(float, a), __builtin_bit_cast(float, b)); }
DI float xhalf_sum(float m) { unsigned a = __builtin_bit_cast(unsigned, m), b = a; swap32(a, b); return __builtin_bit_cast(float, a) + __builtin_bit_cast(float, b); }
DI int crow(int r, int hi) { return (r & 3) + 8 * (r >> 2) + 4 * hi; }

struct AState { float m, l; f32x16 o0, o1; };
DI void astate_init(AState& s) { s.m = M_INIT; s.l = 0.f;
#pragma unroll
    for (int r = 0; r < 16; ++r) { s.o0[r] = 0.f; s.o1[r] = 0.f; } }

template <class MaskF>
DI void attn_tile(AState& st, const LAS unsigned char* kt, const LAS unsigned char* vt, int vd0, const bf16x8 (&qr)[4], LAS float* wsf, int lane, MaskF&& mask) {
    const int r32 = lane & 31, hi = lane >> 5;
    f32x16 p0, p1;
#pragma unroll
    for (int r = 0; r < 16; ++r) { p0[r] = 0.f; p1[r] = 0.f; }
    const LAS unsigned char* kb = kt + r32 * KROW + hi * 16;
#pragma unroll
    for (int d0 = 0; d0 < 4; ++d0) { const bf16x8 a0 = *(const LAS bf16x8*)(kb + d0 * 32), a1 = *(const LAS bf16x8*)(kb + 32 * KROW + d0 * 32);
        p0 = mfma32(a0, qr[d0], p0); p1 = mfma32(a1, qr[d0], p1); }
    mask(p0, p1);
    float rm = fmaxf(p0[0], p1[0]);
#pragma unroll
    for (int r = 1; r < 16; ++r) rm = fmaxf(rm, fmaxf(p0[r], p1[r]));
    rm = xhalf_max(rm);
    if (__any(rm > st.m)) {
        const float mn = fmaxf(st.m, rm), al = __builtin_amdgcn_exp2f(st.m - mn); st.l *= al; st.m = mn;
        if (hi == 0) wsf[r32] = al;
        asm volatile("s_waitcnt lgkmcnt(0)" ::: "memory");
#pragma unroll
        for (int g = 0; g < 4; ++g) { const f32x4 a4 = *(const LAS f32x4*)(wsf + 8 * g + 4 * hi);
#pragma unroll
            for (int i = 0; i < 4; ++i) { st.o0[4 * g + i] *= a4[i]; st.o1[4 * g + i] *= a4[i]; } }
    }
    float sacc = 0.f;
#pragma unroll
    for (int r = 0; r < 16; ++r) { p0[r] = __builtin_amdgcn_exp2f(p0[r] - st.m); p1[r] = __builtin_amdgcn_exp2f(p1[r] - st.m); sacc += p0[r] + p1[r]; }
    st.l += sacc;
    const LAS unsigned char* vb = vt + (4 * hi + ((lane & 15) >> 2)) * 64 + ((lane >> 4) & 1) * 32 + (lane & 3) * 8;
#pragma unroll
    for (int sub = 0; sub < 2; ++sub)
#pragma unroll
        for (int ks = 0; ks < 2; ++ks) {
            u32x4 pw;
            if (sub == 0) { pw.x = cvtpk(p0[8 * ks], p0[8 * ks + 1]); pw.y = cvtpk(p0[8 * ks + 2], p0[8 * ks + 3]); pw.z = cvtpk(p0[8 * ks + 4], p0[8 * ks + 5]); pw.w = cvtpk(p0[8 * ks + 6], p0[8 * ks + 7]); }
            else          { pw.x = cvtpk(p1[8 * ks], p1[8 * ks + 1]); pw.y = cvtpk(p1[8 * ks + 2], p1[8 * ks + 3]); pw.z = cvtpk(p1[8 * ks + 4], p1[8 * ks + 5]); pw.w = cvtpk(p1[8 * ks + 6], p1[8 * ks + 7]); }
            const bf16x8 pa = __builtin_bit_cast(bf16x8, pw);
            const LAS unsigned char* vr = vb + (32 * sub + 16 * ks) * 64;
            { const s16x4 lo = vtr(vr), hh = vtr(vr + 8 * 64); const bf16x8 vf = {lo[0], lo[1], lo[2], lo[3], hh[0], hh[1], hh[2], hh[3]}; st.o0 = mfma32(pa, vf, st.o0); }
            { const s16x4 lo = vtr(vr + vd0), hh = vtr(vr + vd0 + 8 * 64); const bf16x8 vf = {lo[0], lo[1], lo[2], lo[3], hh[0], hh[1], hh[2], hh[3]}; st.o1 = mfma32(pa, vf, st.o1); }
        }
}
template <class RowF>
DI float attn_finish(AState& st, LAS float* wsf, int lane, RowF&& rowp) {
    const int r32 = lane & 31, hi = lane >> 5;
    const float lt = xhalf_sum(st.l);
    if (hi == 0) wsf[32 + r32] = lt;
    asm volatile("s_waitcnt lgkmcnt(0)" ::: "memory");
#pragma unroll
    for (int g = 0; g < 4; ++g) { const f32x4 l4 = *(const LAS f32x4*)(wsf + 32 + 8 * g + 4 * hi);
#pragma unroll
        for (int i = 0; i < 4; ++i) { const float inv = 1.0f / l4[i]; bf16* o = rowp(8 * g + 4 * hi + i);
#ifdef DBG_L
            { const float L = l4[i]; const float a0 = st.o0[4 * g + i], a1 = st.o1[4 * g + i]; const bool obad = !(fabsf(a0) < 1e30f) || !(fabsf(a1) < 1e30f);
              const float c = (L == 0.f) ? 32.f : (L != L) ? 512.f : (fabsf(L) > 1e30f) ? 128.f : (L < 0.99f) ? 2048.f : obad ? 8192.f : 0.f; o[r32] = (bf16)f2bf(c); o[32 + r32] = (bf16)f2bf(c); }
#else
            o[r32] = (bf16)f2bf(st.o0[4 * g + i] * inv); o[32 + r32] = (bf16)f2bf(st.o1[4 * g + i] * inv);
#endif
            } }
    return lt;
}
struct TileRegs { u32x4 k, v; };
DI void tile_load(TileRegs& r, const bf16* krow, const bf16* vrow, int chunk) { r.k = *(const u32x4*)(krow + chunk * 8); r.v = *(const u32x4*)(vrow + chunk * 8); }
DI void tile_store(LAS unsigned char* kt, LAS unsigned char* vt, int vd0, const TileRegs& r, int key, int chunk) {
    *(LAS u32x4*)(kt + key * KROW + chunk * 16) = r.k;
    *(LAS u32x4*)(vt + (chunk >> 2) * vd0 + key * 64 + (chunk & 3) * 16) = r.v;
}
constexpr int AT_K = 64 * KROW, AT_V = 2 * 64 * 64, AT_BUF = AT_K + AT_V;
constexpr int AT_WSF = 2 * AT_BUF;
constexpr int AT_EXTRA = AT_WSF + NWAVES * 256;
DI void load_q(bf16x8 (&qr)[4], const bf16* qrowp  , int hi) {
#pragma unroll
    for (int d0 = 0; d0 < 4; ++d0) qr[d0] = *(const bf16x8*)(qrowp + d0 * 16 + hi * 8);
}
template <class KV, class Act, class MaskT>
DI void attn_run(AState& st, LAS unsigned char* lds, const bf16x8 (&qr)[4], int nt, int tid, int lane, int wave, KV&& kv, Act&& act, MaskT&& mask) {
    const int key = tid >> 3, chunk = tid & 7;
    LAS unsigned char* buf0 = lds; LAS unsigned char* buf1 = lds + AT_BUF; LAS float* wsf = (LAS float*)(lds + AT_WSF) + wave * 64;
    TileRegs tr; const bf16* kp; const bf16* vp;
    kv(0, key, kp, vp); tile_load(tr, kp, vp, chunk); tile_store(buf0, buf0 + AT_K, 4096, tr, key, chunk);
    __syncthreads();
    for (int t = 0; t < nt; ++t) {
        LAS unsigned char* cur = (t & 1) ? buf1 : buf0; LAS unsigned char* nxt = (t & 1) ? buf0 : buf1;
        const bool more = t + 1 < nt;
        if (more) { kv(t + 1, key, kp, vp); tile_load(tr, kp, vp, chunk); }
        if (act(t)) attn_tile(st, cur, cur + AT_K, 4096, qr, wsf, lane, [&](f32x16& p0, f32x16& p1) { mask(t, p0, p1); });
        if (more) tile_store(nxt, nxt + AT_K, 4096, tr, key, chunk);
        __syncthreads();
    }
}
#define CR(r) (((r) & 3) + 8 * ((r) >> 2))
DI void dsa_unit(const Ptrs& P, LAS unsigned char* lds, int b, int qb32) {
    const bf16* PROJ = (const bf16*)(P.ws + WS_R1); const unsigned* MASK = (const unsigned*)(P.ws + WS_MASK); bf16* O = (bf16*)(P.ws + WS_O);
    const int lane = P.lane, r32 = lane & 31, hi = lane >> 5, t0 = 32 * qb32; const size_t rowbase = (size_t)b * SEQ;
    LAS unsigned* ml = (LAS unsigned*)(lds + AT_EXTRA);
#pragma unroll
    for (int k = 0; k < 4; ++k) { const int idx = P.tid + NTHR * k, row = idx >> 6, j = idx & 63; ml[j * 33 + row] = MASK[(rowbase + t0 + row) * 64 + j]; }
    bf16x8 qr[4]; load_q(qr, PROJ + (rowbase + t0 + r32) * EV_NP + C_QA + P.wave * 64, hi);
    AState st; astate_init(st);
    const int nt = (t0 + 32 + 63) >> 6;
    attn_run(st, lds, qr, nt, P.tid, lane, P.wave,
        [&](int t, int key, const bf16*& kp, const bf16*& vp) { const bf16* rp = PROJ + (rowbase + 64 * t + key) * EV_NP; kp = rp + C_KA; vp = rp + C_VA; },
        [&](int) { return true; },
        [&](int t, f32x16& p0, f32x16& p1) { const unsigned w0 = ml[(2 * t) * 33 + r32] >> (4 * hi), w1 = ml[(2 * t + 1) * 33 + r32] >> (4 * hi);
#pragma unroll
            for (int r = 0; r < 16; ++r) { if (!((w0 >> CR(r)) & 1u)) p0[r] = -INFINITY; if (!((w1 >> CR(r)) & 1u)) p1[r] = -INFINITY; } });
    LAS float* wsf = (LAS float*)(lds + AT_WSF) + P.wave * 64;
    (void)attn_finish(st, wsf, lane, [&](int rr) { return O + (rowbase + t0 + rr) * DM + P.wave * 64; });
}
DI void moba_unit(const Ptrs& P, LAS unsigned char* lds, int b, int h, int n) {
    const bf16* PROJ = (const bf16*)(P.ws + WS_R1); const bf16* KM = (const bf16*)(P.ws + WS_MISC + MS_KM); bf16* O = (bf16*)(P.ws + WS_O);
    const int lane = P.lane, r32 = lane & 31, hi = lane >> 5; const size_t rowbase = (size_t)b * SEQ; const int q0 = 256 * n + 32 * P.wave;
    bf16x8 qr[4]; load_q(qr, PROJ + (rowbase + q0 + r32) * EV_NP + C_QB + h * 64, hi);
    unsigned sel = 0u;
    if (n > 0) {
        f32x16 g;
#pragma unroll
        for (int r = 0; r < 16; ++r) g[r] = 0.f;
        const bf16* kmr = KM + (((size_t)b * 8 + h) * 8 + (r32 & 7)) * 64;
#pragma unroll
        for (int d0 = 0; d0 < 4; ++d0) { bf16x8 a = *(const bf16x8*)(kmr + d0 * 16 + hi * 8); if (r32 >= 8) a = (bf16x8){0, 0, 0, 0, 0, 0, 0, 0}; g = mfma32(a, qr[d0], g); }
        float gt[8];
#pragma unroll
        for (int i = 0; i < 4; ++i) { const float own = g[i], oth = __shfl_xor(own, 32); gt[i] = hi ? oth : own; gt[4 + i] = hi ? own : oth; }
#pragma unroll
        for (int round = 0; round < 3; ++round) if (round < n) { float best = -INFINITY; int bi = -1;
#pragma unroll
            for (int j = 0; j < 8; ++j) if (j < n && !((sel >> j) & 1u) && gt[j] > best) { best = gt[j]; bi = j; }
            if (bi >= 0) sel |= 1u << bi; }
    }
    AState st; astate_init(st);
    const int nt = 4 * n + 4;
    attn_run(st, lds, qr, nt, P.tid, lane, P.wave,
        [&](int t, int key, const bf16*& kp, const bf16*& vp) { const bf16* rp = PROJ + (rowbase + 64 * t + key) * EV_NP + h * 64; kp = rp + C_KB; vp = rp + C_VB; },
        [&](int t) { const int blk = t >> 2; if (blk < n) return __any((sel >> blk) & 1u) != 0; return 64 * (t - 4 * n) <= 32 * P.wave + 31; },
        [&](int t, f32x16& p0, f32x16& p1) { const int blk = t >> 2;
            if (blk < n) { if (!((sel >> blk) & 1u)) {
#pragma unroll
                    for (int r = 0; r < 16; ++r) { p0[r] = -INFINITY; p1[r] = -INFINITY; } } }
            else { const int kb = 64 * (t - 4 * n) + 4 * hi, qrel = 32 * P.wave + r32;
#pragma unroll
                for (int r = 0; r < 16; ++r) { if (kb + CR(r) > qrel) p0[r] = -INFINITY; if (kb + 32 + CR(r) > qrel) p1[r] = -INFINITY; } } });
    LAS float* wsf = (LAS float*)(lds + AT_WSF) + P.wave * 64;
    (void)attn_finish(st, wsf, lane, [&](int rr) { return O + (rowbase + q0 + rr) * DM + 512 + h * 64; });
}
DI void phase_attn_even(const Ptrs& P, LAS unsigned char* lds) {
    for (int k = 0; ; ++k) { const int u = P.bid + P.G * k; if (u >= 512) break;
        const int b = u & 7, v = u >> 3, a = v & 31; dsa_unit(P, lds, b, (v >> 5) ? 63 - a : a); }
    for (int k = 0; ; ++k) { const int u = P.bid + P.G * k; if (u >= 512) break;
        const int b = u & 7, h = (u >> 3) & 7, v = u >> 6; moba_unit(P, lds, b, h, v < 4 ? v : 11 - v); }
}
constexpr int B3_K = 128 * KROW, B3_V = 2 * 128 * 64, B3_HALF = B3_K + B3_V, B3_WSF = 2 * B3_HALF;
DI void b3_unit(const Ptrs& P, LAS unsigned char* lds, int b, int h, int rp) {
    const bf16* PROJ = (const bf16*)(P.ws + WS_R1); bf16* O = (bf16*)(P.ws + WS_O); float* LSE3 = (float*)(P.ws + WS_MISC + MS_LSE3);
    const int lane = P.lane, r32 = lane & 31, hi = lane >> 5, half = P.wave >> 2, wi = P.wave & 3, r16 = 2 * rp + half; const size_t rowbase = (size_t)b * SEQ;
    LAS unsigned char* kh = lds + half * B3_HALF; LAS unsigned char* vh = kh + B3_K;
    const int th = P.tid & 255;
#pragma unroll
    for (int k = 0; k < 4; ++k) { const int idx = th + 256 * k, key = idx >> 3, chunk = idx & 7; const bf16* rpn = PROJ + (rowbase + 16 * key + r16) * OD_N + h * 64;
        TileRegs tr; tile_load(tr, rpn + OC_K, rpn + OC_V, chunk); tile_store(kh, vh, 128 * 64, tr, key, chunk); }
    bf16x8 qr[4]; load_q(qr, PROJ + (rowbase + 16 * (32 * wi + r32) + r16) * OD_N + OC_Q + h * 64, hi);
    __syncthreads();
    AState st; astate_init(st);
    LAS float* wsf = (LAS float*)(lds + B3_WSF) + P.wave * 64;
    for (int T = 0; T <= (wi >> 1); ++T)
        attn_tile(st, kh + 64 * T * KROW, vh + 64 * T * 64, 128 * 64, qr, wsf, lane, [&](f32x16& p0, f32x16& p1) { const int kb = 64 * T + 4 * hi, wq = 32 * wi + r32;
#pragma unroll
            for (int r = 0; r < 16; ++r) { if (kb + CR(r) > wq) p0[r] = -INFINITY; if (kb + 32 + CR(r) > wq) p1[r] = -INFINITY; } });
    const float lt = attn_finish(st, wsf, lane, [&](int rr) { return O + (rowbase + 16 * (32 * wi + rr) + r16) * DM + h * 64; });
    if (hi == 0) LSE3[(rowbase + 16 * (32 * wi + r32) + r16) * 16 + h] = st.m + __builtin_amdgcn_logf(lt);
    __syncthreads();
}
DI void phase_b3(const Ptrs& P, LAS unsigned char* lds) {
    for (int k = 0; ; ++k) { const int u = P.bid + P.G * k; if (u >= 1024) break; b3_unit(P, lds, u & 7, (u >> 3) & 15, u >> 7); }
}
DI void band_unit(const Ptrs& P, LAS unsigned char* lds, int b, int h, int qb) {
    const bf16* PROJ = (const bf16*)(P.ws + WS_R1); bf16* O = (bf16*)(P.ws + WS_O); const float* LSE3 = (const float*)(P.ws + WS_MISC + MS_LSE3);
    const int lane = P.lane, r32 = lane & 31, hi = lane >> 5; const size_t rowbase = (size_t)b * SEQ; const int t0w = 256 * qb + 32 * P.wave;
    bf16x8 qr[4]; load_q(qr, PROJ + (rowbase + t0w + r32) * OD_N + OC_Q + h * 64, hi);
    AState st; st.m = LSE3[(rowbase + t0w + r32) * 16 + h]; st.l = hi ? 0.f : 1.f;
#pragma unroll
    for (int r = 0; r < 16; ++r) { const bf16* orow = O + (rowbase + t0w + CR(r) + 4 * hi) * DM + h * 64 + r32; st.o0[r] = bf2f(orow[0]); st.o1[r] = bf2f(orow[32]); }
    const int kt_lo = (4 * qb - 8 > 0) ? 4 * qb - 8 : 0, nt = 4 * qb + 4 - kt_lo;
    attn_run(st, lds, qr, nt, P.tid, lane, P.wave,
        [&](int t, int key, const bf16*& kp, const bf16*& vp) { const bf16* rp = PROJ + (rowbase + 64 * (kt_lo + t) + key) * OD_N + h * 64; kp = rp + OC_K; vp = rp + OC_V; },
        [&](int t) { const int k0 = 64 * (kt_lo + t); return (k0 + 63 >= t0w - 512) && (k0 <= t0w + 31); },
        [&](int t, f32x16& p0, f32x16& p1) { const int dq = (t0w + r32) - (64 * (kt_lo + t) + 4 * hi);
#pragma unroll
            for (int r = 0; r < 16; ++r) {
                { const int d = dq - CR(r); const int mult = ((unsigned)d <= 128u ? 1 : 0) + (((unsigned)d <= 512u && (d & 3) == 0) ? 1 : 0); p0[r] = mult == 0 ? -INFINITY : (mult == 2 ? p0[r] + 1.0f : p0[r]); }
                { const int d = dq - 32 - CR(r); const int mult = ((unsigned)d <= 128u ? 1 : 0) + (((unsigned)d <= 512u && (d & 3) == 0) ? 1 : 0); p1[r] = mult == 0 ? -INFINITY : (mult == 2 ? p1[r] + 1.0f : p1[r]); } } });
    LAS float* wsf = (LAS float*)(lds + AT_WSF) + P.wave * 64;
    (void)attn_finish(st, wsf, lane, [&](int rr) { return O + (rowbase + t0w + rr) * DM + h * 64; });
}
DI void phase_band(const Ptrs& P, LAS unsigned char* lds) {
    for (int k = 0; ; ++k) { const int u = P.bid + P.G * k; if (u >= 1024) break; band_unit(P, lds, u & 7, (u >> 3) & 15, u >> 7); }
}

struct Args { const float* in[20]; float* out; unsigned char* ws; int ph_lo, ph_hi; };
constexpr int NPH_PAIR = 21, NPH = 2 * NPH_PAIR;
constexpr int PT_OFF = LDS_BYTES - 512;
DI unsigned long long uni64(unsigned long long v) { const unsigned lo = __builtin_amdgcn_readfirstlane((unsigned)v), hi = __builtin_amdgcn_readfirstlane((unsigned)(v >> 32)); return ((unsigned long long)hi << 32) | lo; }
DI Ptrs load_ptrs(LAS unsigned char* lds) {
    Ptrs P; const LAS unsigned long long* t = (const LAS unsigned long long*)(lds + PT_OFF);
#pragma unroll
    for (int i = 0; i < 20; ++i) P.in[i] = (const float*)uni64(t[i]);
    P.out = (float*)uni64(t[20]); P.ws = (unsigned char*)uni64(t[21]);
    int tid_ = threadIdx.x; asm volatile("" : "+v"(tid_)); P.tid = tid_; P.lane = P.tid & 63; P.wave = __builtin_amdgcn_readfirstlane(P.tid >> 6); P.bid = blockIdx.x; P.G = gridDim.x;
    return P;
}
DI void grid_bar(LAS unsigned char* lds) {
    const Ptrs P = load_ptrs(lds);
    XcdBarrier bar; bar.bar = (unsigned*)(P.ws + WS_CTL) + CW_BAR; bar.x = xb_xcc_id(); bar.st = (volatile LAS unsigned*)(lds + LDS_BYTES - 16);
    xcd_barrier(bar);
}
__global__ void __launch_bounds__(NTHR, 2) fwd(Args args) {
    extern __shared__ __attribute__((aligned(16))) unsigned char lds_raw[];
    LAS unsigned char* lds = (LAS unsigned char*)lds_raw;
    const int lo = args.ph_lo, hi = args.ph_hi;
    {   LAS unsigned long long* t = (LAS unsigned long long*)(lds + PT_OFF);
        if (threadIdx.x == 0) {
#pragma unroll
            for (int i = 0; i < 20; ++i) t[i] = (unsigned long long)args.in[i];
            t[20] = (unsigned long long)args.out; t[21] = (unsigned long long)args.ws; }
        volatile LAS unsigned* bst = (volatile LAS unsigned*)(lds + LDS_BYTES - 16);
        if (threadIdx.x == 0) { bst[0] = 0u; bst[1] = 0u; }
        __syncthreads();
        if (hi - lo > 1) (void)xcd_barrier_post((unsigned*)(args.ws + WS_CTL) + CW_BAR, bst);
    }
#define PTRS() const Ptrs P = load_ptrs(lds); bf16* WIN = (bf16*)(P.ws + WS_WIN); bf16* WOUT = (bf16*)(P.ws + WS_WOUT); bf16* WUP = (bf16*)(P.ws + WS_WUP); bf16* WDN = (bf16*)(P.ws + WS_WDN); \
    float* XF = (float*)(P.ws + WS_XF); bf16* XB = (bf16*)(P.ws + WS_XB); bf16* PROJ = (bf16*)(P.ws + WS_R1); bf16* OB = (bf16*)(P.ws + WS_O); bf16* HB = (bf16*)(P.ws + WS_R1); \
    float* MIX = (float*)(P.ws + WS_MIX); bf16* XBUF = (bf16*)(P.ws + WS_XBUF); const int* pblk = (const int*)(P.ws + WS_MISC + MS_PBLK); \
    (void)WIN; (void)WOUT; (void)WUP; (void)WDN; (void)XF; (void)XB; (void)PROJ; (void)OB; (void)HB; (void)MIX; (void)XBUF; (void)pblk;

    for (int pair = 0; pair < 2; ++pair) {
        const int base = pair * NPH_PAIR;
#ifndef PHMASK
#define PHMASK 0x1fffff
#endif
#define IN(k) (((PHMASK >> (k)) & 1) && lo <= base + (k) && base + (k) < hi)
#define SEAM(k) do { if (base + (k) + 1 < hi) grid_bar(lds); } while (0)
        if (IN(0)) { PTRS(); if (pair == 0) phase_init(P); phase_convert_even(P, lds, pair); SEAM(0); }
        if (IN(1)) { PTRS(); pg8::Gemm g{XB, WIN, NTOK, EV_NP, DM}; pg8::StaticOrder S; S.init(NTOK, EV_NP, P.G, P.bid); pg8::EpiStoreBf16 E{PROJ, EV_NP};
            pg8::gemm_phase<pg8::EpiStoreBf16, pg8::StaticOrder, true, true>(lds, g, S, E); SEAM(1); }
        if (IN(2)) { PTRS(); phase_rope_even(P); SEAM(2); }
        if (IN(3)) { PTRS(); phase_index(P, lds); SEAM(3); }
        if (IN(4)) { PTRS(); phase_attn_even(P, lds); SEAM(4); }
        if (IN(5)) { PTRS(); pg8::Gemm g{OB, WOUT, NTOK, DM, DM}; pg8::StaticOrder S; S.init(NTOK, DM, P.G, P.bid); pg8::EpiF32 E{MIX, DM, pair == 0 ? P.in[0] : (const float*)XF, ALPHA};
            pg8::gemm_phase<pg8::EpiF32, pg8::StaticOrder, true, true>(lds, g, S, E); SEAM(5); }
        if (IN(6)) { PTRS(); phase_ln<false>(P, lds, P.in[3] + pair * DM, P.in[4] + pair * DM, XF, XB, nullptr); SEAM(6); }
        if (IN(7)) { PTRS(); pg8::Gemm g{XB, WUP, NTOK, 2 * FF, DM}; pg8::StaticOrder S; S.init(NTOK, 2 * FF, P.G, P.bid); pg8::EpiSwiGLU E{HB, FF};
            pg8::gemm_phase<pg8::EpiSwiGLU, pg8::StaticOrder, true, true>(lds, g, S, E); SEAM(7); }
        if (IN(8)) { PTRS(); pg8::Gemm g{HB, WDN, NTOK, DM, FF}; pg8::StaticOrder S; S.init(NTOK, DM, P.G, P.bid); pg8::EpiF32 E{MIX, DM, XF, ALPHA};
            pg8::gemm_phase<pg8::EpiF32, pg8::StaticOrder, true, true>(lds, g, S, E); SEAM(8); }
        if (IN(9)) { PTRS(); phase_ln<false>(P, lds, P.in[8] + pair * DM, P.in[9] + pair * DM, XF, XB, nullptr); SEAM(9); }
        if (IN(10)) { PTRS(); phase_convert_odd(P, lds, pair); SEAM(10); }
        if (IN(11)) { PTRS(); pg8::Gemm g{XB, WIN, NTOK, OD_N, DM}; pg8::StaticOrder S; S.init(NTOK, OD_N, P.G, P.bid); pg8::EpiStoreBf16 E{PROJ, OD_N};
            pg8::gemm_phase<pg8::EpiStoreBf16, pg8::StaticOrder, true, true>(lds, g, S, E); SEAM(11); }
        if (IN(12)) { PTRS(); phase_rope_odd(P); SEAM(12); }
        if (IN(13)) { PTRS(); phase_b3(P, lds); SEAM(13); }
        if (IN(14)) { PTRS(); phase_band(P, lds); SEAM(14); }
        if (IN(15)) { PTRS(); pg8::Gemm g{OB, WOUT, NTOK, DM, DM}; pg8::StaticOrder S; S.init(NTOK, DM, P.G, P.bid); pg8::EpiF32 E{MIX, DM, XF, ALPHA};
            pg8::gemm_phase<pg8::EpiF32, pg8::StaticOrder, true, true>(lds, g, S, E); SEAM(15); }
        if (IN(16)) { PTRS(); phase_ln<true>(P, lds, P.in[12] + pair * DM, P.in[13] + pair * DM, XF, XB, P.in[14] + (size_t)pair * DM * NEXP); SEAM(16); }
        if (IN(17)) { PTRS(); phase_route(P, lds); SEAM(17); }
        if (IN(18)) { PTRS(); pg8::Gemm g{XBUF, WUP, MOE_ROWS, 2 * FFE, DM}; pg8::MoeOrder S; S.init(pblk, 2 * FFE / 256, (long)2 * FFE * DM * 2, P.G, P.bid); pg8::EpiSwiGLU E{HB, FFE};
            pg8::gemm_phase<pg8::EpiSwiGLU, pg8::MoeOrder, true, true>(lds, g, S, E); SEAM(18); }
        if (IN(19)) { PTRS(); pg8::Gemm g{HB, WDN, MOE_ROWS, DM, FFE}; pg8::MoeOrder S; S.init(pblk, DM / 256, (long)DM * FFE * 2, P.G, P.bid); pg8::EpiF32 E{MIX, DM, nullptr, 0.f};
            pg8::gemm_phase<pg8::EpiF32, pg8::MoeOrder, true, true>(lds, g, S, E); SEAM(19); }
        if (IN(20)) { PTRS(); phase_moe_combine(P, P.in[18] + pair * DM, P.in[19] + pair * DM, pair == 1 ? P.out : XF, pair == 1 ? nullptr : XB); SEAM(20); }
#undef IN
#undef SEAM
    }
}

#ifdef DBG_STOP
__global__ void dbg_dump(float* out, const unsigned char* ws, const float* x, int src) {
    const size_t n = (size_t)NTOK * DM;
    for (size_t i = (size_t)blockIdx.x * blockDim.x + threadIdx.x; i < n; i += (size_t)gridDim.x * blockDim.x) {
        float v;
        switch (src) {
            case 0: v = x[i]; break;
            case 1: v = bf2f(((const bf16*)(ws + WS_XB))[i]); break;
            case 2: v = bf2f(((const bf16*)(ws + WS_R1))[i]); break;
            case 3: v = ((const float*)(ws + WS_MIX))[i]; break;
            case 4: v = ((const float*)(ws + WS_XF))[i]; break;
            case 5: v = bf2f(((const bf16*)(ws + WS_O))[i]); break;
            case 8: { const float o = bf2f(((const bf16*)(ws + WS_O))[i]); const bool bad = !(fabsf(o) < 1e30f); v = ((i & 1023) < 512) ? (bad ? 1000.f : 0.f) : 0.f; } break;
            case 10: { const float o = bf2f(((const bf16*)(ws + WS_O))[i]); const bool bad = !(fabsf(o) < 1e30f); const int t = (int)((i >> 10) & 2047); v = ((i & 1023) < 512 && bad) ? 32.f * (float)(1 << (t >> 8)) : 0.f; } break;
            case 11: { const float o = bf2f(((const bf16*)(ws + WS_O))[i]); const bool bad = !(fabsf(o) < 1e30f); const int b = (int)(i >> 21); v = ((i & 1023) < 512 && bad) ? 32.f * (float)(1 << b) : 0.f; } break;
            case 12: { const float o = bf2f(((const bf16*)(ws + WS_O))[i]); const bool bad = !(fabsf(o) < 1e30f); const int t = (int)((i >> 10) & 2047); v = ((i & 1023) < 512 && bad) ? 32.f * (float)(1 << ((t >> 5) & 7)) : 0.f; } break;
            case 13: { const float o = bf2f(((const bf16*)(ws + WS_O))[i]); const bool bad = !(fabsf(o) < 1e30f); const int hh = (int)((i >> 6) & 7); v = ((i & 1023) < 512 && bad) ? 32.f * (float)(1 << hh) : 0.f; } break;
            case 14: { v = 0.f; if ((i & 1023) == 0) { const int row = (int)(i >> 10); int cnt = 0; for (int w = 0; w < 64; ++w) cnt += __popc(((const unsigned*)(ws + WS_MASK))[row * 64 + w]); const int t = row & 2047; const int ex = t + 1 < 256 ? t + 1 : 256; v = (cnt != ex) ? 1000.f : 0.f; } } break;
            case 15: { const float o = bf2f(((const bf16*)(ws + WS_O))[i]); v = ((i & 1023) < 512) ? o : 0.f; } break;
            case 9: { const float o = bf2f(((const bf16*)(ws + WS_O))[i]); const bool bad = !(fabsf(o) < 1e30f); v = ((i & 1023) >= 512) ? (bad ? 1000.f : 0.f) : 0.f; } break;
            case 6: v = (float)(((const unsigned*)(ws + WS_MASK))[i & (NTOK * 64 - 1)] & 0xffffu); break;
            case 7: v = bf2f(((const bf16*)(ws + WS_WUP))[i]); break;
            default: v = 0.f;
        }
        out[i] = v;
    }
}
#endif
#ifndef MK_SPLIT
#define MK_SPLIT 1
#endif
extern "C" void kernel_launch(void* const* d_in, const int* in_sizes, int n_in, void* d_out, int out_size, void* d_ws, size_t ws_size, hipStream_t stream) {
    static int grid = 0;
    if (grid == 0) {
        if (n_in != 20 || in_sizes[0] != NTOK * DM || out_size != NTOK * DM || ws_size < WS_END) { fprintf(stderr, "kernel_launch: unexpected problem (n_in %d, in0 %d, out %d, ws %zu); nothing launched\n", n_in, n_in > 0 ? in_sizes[0] : -1, out_size, ws_size); grid = -1; return; }
        int dev = 0, cus = 0, per_cu = 0;
        if (hipGetDevice(&dev) != hipSuccess || hipDeviceGetAttribute(&cus, hipDeviceAttributeMultiprocessorCount, dev) != hipSuccess) { grid = -1; return; }
        if (hipFuncSetAttribute((const void*)fwd, hipFuncAttributeMaxDynamicSharedMemorySize, LDS_BYTES) != hipSuccess) { fprintf(stderr, "kernel_launch: hipFuncSetAttribute failed\n"); grid = -1; return; }
        if (hipOccupancyMaxActiveBlocksPerMultiprocessor(&per_cu, (const void*)fwd, NTHR, LDS_BYTES) != hipSuccess || per_cu < 1) fprintf(stderr, "kernel_launch: note: occupancy query reports %d\n", per_cu);
        (void)hipGetLastError();
        grid = cus;
    }
    if (grid < 0) return;
    if (hipMemsetAsync((char*)d_ws + WS_CTL, 0, CTL_ZERO_BYTES, stream) != hipSuccess) return;
    Args a{};
    for (int i = 0; i < 20; ++i) a.in[i] = (const float*)d_in[i];
    a.out = (float*)d_out; a.ws = (unsigned char*)d_ws;
#ifdef DBG_STOP
    for (int p = 0; p < DBG_STOP; ++p) { a.ph_lo = p; a.ph_hi = p + 1; hipLaunchKernelGGL(fwd, dim3(grid), dim3(NTHR), LDS_BYTES, stream, a); }
    hipLaunchKernelGGL(dbg_dump, dim3(1024), dim3(256), 0, stream, (float*)d_out, (const unsigned char*)d_ws, (const float*)d_in[0], (int)DBG_SRC);
#elif MK_SPLIT
    for (int p = 0; p < NPH; ++p) { a.ph_lo = p; a.ph_hi = p + 1; hipLaunchKernelGGL(fwd, dim3(grid), dim3(NTHR), LDS_BYTES, stream, a); }
#else
    a.ph_lo = 0; a.ph_hi = NPH; hipLaunchKernelGGL(fwd, dim3(grid), dim3(NTHR), LDS_BYTES, stream, a);
#endif
}
```

```cpp
#include <hip/hip_runtime.h>
#include <cstdio>
#include <cstdint>
#define MK_SPLIT 0
namespace pg8 {
#define PG8_LAS __attribute__((address_space(3)))
typedef unsigned short bf16_t;
typedef short bf16x8 __attribute__((ext_vector_type(8)));
typedef float f32x4 __attribute__((ext_vector_type(4)));
typedef unsigned u32x4 __attribute__((ext_vector_type(4)));
constexpr int BM = 256, BK = 64, HALF = 128, HTB = HALF * BK * 2  , STAGE_BYTES = 8 * HTB, NXCD = 8, WGM = 8;

__host__ __device__ __forceinline__ int lds_byte(int r, int c) { const int st = (r >> 4) * 2 + (c >> 5), rr = r & 15, cc = c & 31, ob = rr * 64 + cc * 2; return st * 1024 + (ob ^ (((ob >> 9) & 1) << 5)); }
__host__ __device__ __forceinline__ void stage_rc(int b, int& R, int& C) { const int st = b / 1024, sb = b % 1024, swz = sb ^ (((sb >> 9) & 1) << 5); R = (st >> 1) * 16 + swz / 64; C = (st & 1) * 32 + (swz % 64) / 2; }
__host__ __device__ __forceinline__ int perm32(int rho) { const int n = rho >> 4, i = rho & 15; return 8 * (i >> 2) + 4 * n + (i & 3); }

struct Unit { int pm, pn; long boff; };
struct Gemm { const bf16_t* A; const bf16_t* Bt; int M, N, K; };

struct StaticOrder {
    int nM, nN, nwg, G, c;
    __host__ __device__ void init(int M, int N, int G_, int c_) { nM = M / BM; nN = N / BM; nwg = nM * nN; G = G_; c = c_; }
    __host__ __device__ bool next(int i, Unit& u) const {
        const long L = (long)i * G + c; if (L >= nwg) return false;
        int wgid = (int)L; { const int q = nwg / NXCD, r = nwg % NXCD, xcd = wgid % NXCD, off = wgid / NXCD; wgid = (xcd < r ? xcd * (q + 1) : r * (q + 1) + (xcd - r) * q) + off; }
        const int nig = WGM * nN, gid = wgid / nig, fm = gid * WGM, gsz = (nM - fm) < WGM ? (nM - fm) : WGM;
        u.pm = fm + ((wgid % nig) % gsz); u.pn = (wgid % nig) / gsz; u.boff = 0; return true;
    }
    __device__ __forceinline__ void a_ready(const Unit&) const {}
    __device__ __forceinline__ void done(const Unit&) const {}
};

__device__ __forceinline__ unsigned cvt_pk_bf16(float lo, float hi) { unsigned r; asm volatile("v_cvt_pk_bf16_f32 %0, %1, %2" : "=v"(r) : "v"(lo), "v"(hi)); return r; }
struct EpiStoreBf16 {
    static constexpr bool PERM = true, AFTER_DRAIN = false;
    bf16_t* O; int ldc;
    __device__ __forceinline__ void operator()(const f32x4 (&acc)[2][2][4][2], const Unit& u, int wr, int wc, int fr, int fq) const {
        const int row0 = u.pm * BM + wr * 64 + fr, col0 = u.pn * BM + wc * 32 + 8 * fq;
#pragma unroll
        for (int ai = 0; ai < 2; ++ai)
#pragma unroll
            for (int m = 0; m < 4; ++m) { bf16_t* rowp = O + (size_t)(row0 + ai * HALF + m * 16) * ldc + col0;
#pragma unroll
                for (int bj = 0; bj < 2; ++bj) { const f32x4 v0 = acc[ai][bj][m][0], v1 = acc[ai][bj][m][1];
                    u32x4 w; w.x = cvt_pk_bf16(v0[0], v0[1]); w.y = cvt_pk_bf16(v0[2], v0[3]); w.z = cvt_pk_bf16(v1[0], v1[1]); w.w = cvt_pk_bf16(v1[2], v1[3]);
                    *(u32x4*)(rowp + bj * HALF) = w; } }
    }
};
__device__ __forceinline__ float silu_mul(float g, float u) { return g * u * __builtin_amdgcn_rcpf(1.0f + __builtin_amdgcn_exp2f(-1.4426950408889634f * g)); }
struct EpiSwiGLU {
    static constexpr bool PERM = true, AFTER_DRAIN = false;
    bf16_t* H; int ldh;
    __device__ __forceinline__ void operator()(const f32x4 (&acc)[2][2][4][2], const Unit& u, int wr, int wc, int fr, int fq) const {
        const int row0 = u.pm * BM + wr * 64 + fr, col0 = u.pn * HALF + wc * 32 + 8 * fq;
#pragma unroll
        for (int ai = 0; ai < 2; ++ai)
#pragma unroll
            for (int m = 0; m < 4; ++m) { bf16_t* rowp = H + (size_t)(row0 + ai * HALF + m * 16) * ldh + col0;
                const f32x4 g0 = acc[ai][0][m][0], g1 = acc[ai][0][m][1], u0 = acc[ai][1][m][0], u1 = acc[ai][1][m][1];
                u32x4 w; w.x = cvt_pk_bf16(silu_mul(g0[0], u0[0]), silu_mul(g0[1], u0[1])); w.y = cvt_pk_bf16(silu_mul(g0[2], u0[2]), silu_mul(g0[3], u0[3]));
                w.z = cvt_pk_bf16(silu_mul(g1[0], u1[0]), silu_mul(g1[1], u1[1])); w.w = cvt_pk_bf16(silu_mul(g1[2], u1[2]), silu_mul(g1[3], u1[3]));
                *(u32x4*)rowp = w; }
    }
};
struct EpiF32 {
    static constexpr bool PERM = false, AFTER_DRAIN = false;
    float* O; int ldc; const float* R; float alpha;
    __device__ __forceinline__ void operator()(const f32x4 (&acc)[2][2][4][2], const Unit& u, int wr, int wc, int fr, int fq) const {
        const int row0 = u.pm * BM + wr * 64 + fr, col0 = u.pn * BM + wc * 32 + 4 * fq;
#pragma unroll
        for (int ai = 0; ai < 2; ++ai)
#pragma unroll
            for (int m = 0; m < 4; ++m) { const size_t off = (size_t)(row0 + ai * HALF + m * 16) * ldc + col0;
#pragma unroll
                for (int bj = 0; bj < 2; ++bj)
#pragma unroll
                    for (int n = 0; n < 2; ++n) { f32x4 v = acc[ai][bj][m][n]; if (R) v += alpha * *(const f32x4*)(R + off + bj * HALF + n * 16); *(f32x4*)(O + off + bj * HALF + n * 16) = v; } }
    }
};
struct MoeOrder {
    int nN, nunits, G, c; long estride; int pb[9];
    __device__ __forceinline__ void init(const int* pblk, int nN_, long estride_, int G_, int c_) { nN = nN_; G = G_; c = c_; estride = estride_;
#pragma unroll
        for (int e = 0; e < 9; ++e) pb[e] = __builtin_amdgcn_readfirstlane(pblk[e]);
        nunits = pb[8] * nN; }
    __device__ __forceinline__ bool next(int i, Unit& u) const {
        const int L = i * G + c; if (L >= nunits) return false;
        u.pm = L / nN; u.pn = L - u.pm * nN; int e = 0;
#pragma unroll
        for (int k = 1; k < 8; ++k) e += (u.pm >= pb[k]) ? 1 : 0;
        u.boff = (long)e * estride; return true; }
    __device__ __forceinline__ void a_ready(const Unit&) const {}
    __device__ __forceinline__ void done(const Unit&) const {}
};
template <class Epi, class Sched, bool ALIGN_EPI = false, bool SP2 = false>
__device__ __forceinline__ void gemm_phase(PG8_LAS unsigned char* lds, const Gemm g, const Sched& S, const Epi& E) {
    int tid_ = threadIdx.x; asm volatile("" : "+v"(tid_));
    const int tid = tid_, wid = __builtin_amdgcn_readfirstlane(tid >> 6), lane = tid & 63, wr = wid >> 2, wc = wid & 3, fr = lane & 15, fq = lane >> 4;
    const int K = g.K, nt = K / BK;
    unsigned voffA[2], voffB[2];
#pragma unroll
    for (int i = 0; i < 2; ++i) { int R, C; stage_rc(tid * 16 + i * 8192, R, C); const int Rb = Epi::PERM ? ((R & ~31) + perm32(R & 31)) : R;
        voffA[i] = (unsigned)(R * K + C) * 2u; voffB[i] = (unsigned)(Rb * K + C) * 2u; }
    const size_t kstep = (size_t)(BK * 2);
    const size_t hstep = (size_t)HALF * K * 2;
    const size_t tstep = 2 * hstep;
    const unsigned ldsw = (unsigned)wid * 1024u;
    const int aoff = lds_byte(wr * 64 + fr, fq * 8), boff = lds_byte(wc * 32 + fr, fq * 8);
#define PG8_SA(b, h) (((b) * 2 + (h)) * HTB)
#define PG8_SB(b, h) ((4 + (b) * 2 + (h)) * HTB)
#define PG8_STAGE(bufoff, gbase, voff) do { _Pragma("unroll") for (int _i = 0; _i < 2; ++_i) \
        __builtin_amdgcn_global_load_lds((const unsigned*)((const char*)(gbase) + (voff)[_i]), (PG8_LAS unsigned*)(lds + (bufoff) + ldsw + _i * 8192), 16, 0, 0); } while (0)
#define PG8_LDA(dst, b, h) do { _Pragma("unroll") for (int m = 0; m < 4; ++m) _Pragma("unroll") for (int k = 0; k < 2; ++k) dst[m][k] = *(const PG8_LAS bf16x8*)(lds + PG8_SA(b, h) + aoff + m * 2048 + k * 1024); } while (0)
#define PG8_LDB(dst, b, h) do { _Pragma("unroll") for (int n = 0; n < 2; ++n) _Pragma("unroll") for (int k = 0; k < 2; ++k) dst[n][k] = *(const PG8_LAS bf16x8*)(lds + PG8_SB(b, h) + boff + n * 2048 + k * 1024); } while (0)
#define PG8_MMA(ai, bj, At, Bt) do { __builtin_amdgcn_s_setprio(1); _Pragma("unroll") for (int m = 0; m < 4; ++m) _Pragma("unroll") for (int n = 0; n < 2; ++n) _Pragma("unroll") for (int k = 0; k < 2; ++k) \
        acc[ai][bj][m][n] = __builtin_amdgcn_mfma_f32_16x16x32_bf16(Bt[n][k], At[m][k], acc[ai][bj][m][n], 0, 0, 0); __builtin_amdgcn_s_setprio(0); } while (0)
#define PG8_WAIT_V(n) asm volatile("s_waitcnt vmcnt(" #n ")" ::: "memory")
#define PG8_WAIT_L(n) asm volatile("s_waitcnt lgkmcnt(" #n ")" ::: "memory")
#define PG8_BAR __builtin_amdgcn_s_barrier()
#define PG8_SCHED __builtin_amdgcn_sched_barrier(0)
    Unit cur, nxt; int ui = 0;
    if (!S.next(0, cur)) return;
    f32x4 acc[2][2][4][2];
#pragma unroll
    for (int a = 0; a < 2; ++a)
#pragma unroll
        for (int b = 0; b < 2; ++b)
#pragma unroll
            for (int m = 0; m < 4; ++m)
#pragma unroll
                for (int n = 0; n < 2; ++n) acc[a][b][m][n] = (f32x4){0.f, 0.f, 0.f, 0.f};
    bf16x8 At[4][2], B0[2][2], B1[2][2];
    const char* cA = (const char*)g.A + (size_t)cur.pm * tstep; const char* cB = (const char*)g.Bt + cur.boff + (size_t)cur.pn * tstep;
    S.a_ready(cur);
    if constexpr (SP2) {
        PG8_STAGE(PG8_SB(0, 0), cB, voffB); PG8_STAGE(PG8_SB(0, 1), cB + hstep, voffB); PG8_STAGE(PG8_SA(0, 0), cA, voffA); PG8_STAGE(PG8_SA(0, 1), cA + hstep, voffA);
        if (wr == 1) PG8_BAR;
        PG8_WAIT_V(2); PG8_BAR;
        PG8_STAGE(PG8_SB(1, 0), cB + kstep, voffB); PG8_STAGE(PG8_SA(1, 0), cA + kstep, voffA); PG8_STAGE(PG8_SB(1, 1), cB + hstep + kstep, voffB);
        PG8_WAIT_V(6); PG8_BAR;
    } else {
        PG8_STAGE(PG8_SB(0, 0), cB, voffB); PG8_STAGE(PG8_SA(0, 0), cA, voffA); PG8_STAGE(PG8_SB(0, 1), cB + hstep, voffB); PG8_STAGE(PG8_SA(0, 1), cA + hstep, voffA);
        if (wr == 1) PG8_BAR;
        PG8_WAIT_V(4); PG8_BAR;
        PG8_STAGE(PG8_SB(1, 0), cB + kstep, voffB); PG8_STAGE(PG8_SA(1, 0), cA + kstep, voffA); PG8_STAGE(PG8_SB(1, 1), cB + hstep + kstep, voffB);
        PG8_WAIT_V(6); PG8_BAR;
    }
    for (;;) {
        const bool has_next = S.next(ui + 1, nxt);
        const char* nA = has_next ? (const char*)g.A + (size_t)nxt.pm * tstep : cA; const char* nB = has_next ? (const char*)g.Bt + nxt.boff + (size_t)nxt.pn * tstep : cB;
        for (int t = 0; t < nt; t += 2) {
            const bool last = (t == nt - 2);
            const char* a1 = cA + (size_t)(t + 1) * kstep;
            const char* a2 = last ? nA : cA + (size_t)(t + 2) * kstep; const char* b2 = last ? nB : cB + (size_t)(t + 2) * kstep;
            const char* a3 = a2 + kstep; const char* b3 = b2 + kstep;
            if (last && has_next) S.a_ready(nxt);
            if constexpr (SP2) {
            PG8_LDB(B0, 0, 0); PG8_LDB(B1, 0, 1); PG8_SCHED; PG8_LDA(At, 0, 0); PG8_STAGE(PG8_SA(1, 1), a1 + hstep, voffA);
            PG8_WAIT_V(8); PG8_WAIT_L(0); PG8_BAR; PG8_MMA(0, 0, At, B0); PG8_MMA(0, 1, At, B1); PG8_BAR; PG8_SCHED;
            PG8_LDA(At, 0, 1); PG8_STAGE(PG8_SB(0, 0), b2, voffB); PG8_STAGE(PG8_SB(0, 1), b2 + hstep, voffB); PG8_STAGE(PG8_SA(0, 0), a2, voffA);
            PG8_WAIT_V(8); PG8_WAIT_L(0); PG8_BAR; PG8_MMA(1, 0, At, B0); PG8_MMA(1, 1, At, B1); PG8_BAR; PG8_SCHED;
            PG8_LDB(B0, 1, 0); PG8_LDB(B1, 1, 1); PG8_SCHED; PG8_LDA(At, 1, 0); PG8_STAGE(PG8_SA(0, 1), a2 + hstep, voffA);
            PG8_WAIT_V(8); PG8_WAIT_L(0); PG8_BAR; PG8_MMA(0, 0, At, B0); PG8_MMA(0, 1, At, B1); PG8_BAR; PG8_SCHED;
            PG8_LDA(At, 1, 1); PG8_STAGE(PG8_SB(1, 0), b3, voffB); PG8_STAGE(PG8_SB(1, 1), b3 + hstep, voffB); PG8_STAGE(PG8_SA(1, 0), a3, voffA);
            PG8_WAIT_V(8); PG8_WAIT_L(0); PG8_BAR; PG8_MMA(1, 0, At, B0); PG8_MMA(1, 1, At, B1); PG8_BAR; PG8_SCHED;
            } else {
            PG8_LDB(B0, 0, 0); PG8_SCHED; PG8_LDA(At, 0, 0); PG8_STAGE(PG8_SA(1, 1), a1 + hstep, voffA);
            PG8_WAIT_L(8); PG8_BAR; PG8_WAIT_L(0); PG8_MMA(0, 0, At, B0); PG8_BAR; PG8_SCHED;
            PG8_LDB(B1, 0, 1); PG8_STAGE(PG8_SB(0, 0), b2, voffB);
            PG8_BAR; PG8_WAIT_L(0); PG8_MMA(0, 1, At, B1); PG8_BAR;
            PG8_LDA(At, 0, 1); PG8_STAGE(PG8_SA(0, 0), a2, voffA);
            PG8_BAR; PG8_WAIT_L(0); PG8_MMA(1, 0, At, B0); PG8_BAR; PG8_SCHED;
            PG8_STAGE(PG8_SB(0, 1), b2 + hstep, voffB);
            PG8_WAIT_V(6); PG8_BAR; PG8_MMA(1, 1, At, B1); PG8_BAR;
            PG8_LDB(B0, 1, 0); PG8_SCHED; PG8_LDA(At, 1, 0); PG8_STAGE(PG8_SA(0, 1), a2 + hstep, voffA);
            PG8_WAIT_L(8); PG8_BAR; PG8_WAIT_L(0); PG8_MMA(0, 0, At, B0); PG8_BAR; PG8_SCHED;
            PG8_LDB(B1, 1, 1); PG8_STAGE(PG8_SB(1, 0), b3, voffB);
            PG8_BAR; PG8_WAIT_L(0); PG8_MMA(0, 1, At, B1); PG8_BAR;
            PG8_LDA(At, 1, 1); PG8_STAGE(PG8_SA(1, 0), a3, voffA);
            PG8_BAR; PG8_WAIT_L(0); PG8_MMA(1, 0, At, B0); PG8_BAR; PG8_SCHED;
            PG8_STAGE(PG8_SB(1, 1), b3 + hstep, voffB);
            PG8_WAIT_V(6); PG8_BAR; PG8_MMA(1, 1, At, B1); PG8_BAR;
            }
        }
        if constexpr (ALIGN_EPI) { if (wr == 0) PG8_BAR; }
        if constexpr (!Epi::AFTER_DRAIN) { E(acc, cur, wr, wc, fr, fq); S.done(cur); }
        if (!has_next) break;
#pragma unroll
        for (int a = 0; a < 2; ++a)
#pragma unroll
            for (int b = 0; b < 2; ++b)
#pragma unroll
                for (int m = 0; m < 4; ++m)
#pragma unroll
                    for (int n = 0; n < 2; ++n) acc[a][b][m][n] = (f32x4){0.f, 0.f, 0.f, 0.f};
        cur = nxt; cA = nA; cB = nB; ++ui;
        if constexpr (ALIGN_EPI) { if (wr == 1) PG8_BAR; }
    }
    PG8_WAIT_V(0);
    if constexpr (!ALIGN_EPI) { if (wr == 0) PG8_BAR; }
    PG8_BAR;
    if constexpr (Epi::AFTER_DRAIN) { E.fused(acc, cur, wr, wc, fr, fq, lds, wid, lane); S.done(cur); }
#undef PG8_SA
#undef PG8_SB
#undef PG8_STAGE
#undef PG8_LDA
#undef PG8_LDB
#undef PG8_MMA
#undef PG8_WAIT_V
#undef PG8_WAIT_L
#undef PG8_BAR
#undef PG8_SCHED
}
}

#define DI __device__ __forceinline__
#define LAS __attribute__((address_space(3)))
typedef unsigned short bf16;
typedef unsigned u32x4 __attribute__((ext_vector_type(4)));
typedef unsigned u32x2 __attribute__((ext_vector_type(2)));
typedef float f32x4 __attribute__((ext_vector_type(4)));
typedef float f32x2 __attribute__((ext_vector_type(2)));
typedef float f32x16 __attribute__((ext_vector_type(16)));
typedef short bf16x8 __attribute__((ext_vector_type(8)));
typedef short s16x4 __attribute__((ext_vector_type(4)));
typedef unsigned gu32;

constexpr int NB = 8, SEQ = 2048, DM = 1024, NTOK = NB * SEQ;
constexpr int EV_N = 2472, EV_NP = 2560, OD_N = 3072;
constexpr int FF = 2816, FFE = 3584, NEXP = 8;
constexpr int C_QA = 0, C_KA = 512, C_VA = 576, C_IQ = 640, C_IK = 896, C_IW = 928, C_QB = 936, C_KB = 1448, C_VB = 1960;
constexpr int OC_Q = 0, OC_K = 1024, OC_V = 2048;
constexpr float ALPHA = 1.6817928305074290f;
constexpr float LN_EPS = 1e-5f;
constexpr float QSCALE = 0.125f * 1.4426950408889634f;
constexpr int MOE_ROWS = 2 * NTOK + NEXP * 256;
constexpr int NWAVES = 8, NTHR = 512;

constexpr size_t MiB = 1u << 20;
constexpr size_t WS_CTL = 0, CTL_ZERO_BYTES = 1 * MiB;
constexpr size_t WS_TAB = 1 * MiB;
constexpr size_t WS_MISC = 2 * MiB;
constexpr size_t WS_MASK = 6 * MiB;
constexpr size_t WS_WIN = 10 * MiB, WS_WOUT = 18 * MiB, WS_WUP = 20 * MiB, WS_WDN = 132 * MiB;
constexpr size_t WS_XF = 188 * MiB, WS_XB = 252 * MiB;
constexpr size_t WS_R1 = 284 * MiB;
constexpr size_t WS_O = WS_R1 + 96 * MiB;
constexpr size_t WS_MIX = 524 * MiB;
constexpr size_t WS_XBUF = 660 * MiB;
constexpr size_t WS_END = 728 * MiB;
constexpr size_t MS_EID = 0, MS_GATE = 128 * 1024, MS_ROWOF = 256 * 1024, MS_TOKOF = 384 * 1024, MS_KM = 640 * 1024, MS_PBLK = 768 * 1024, MS_LSE3 = 1 * MiB;
constexpr size_t TB_COS64 = 0, TB_SIN64 = 256 * 1024, TB_COS32 = 512 * 1024, TB_SIN32 = 640 * 1024;
constexpr int CW_TMO = 0, CW_BAR = 4096;

constexpr int LDS_BYTES = 152 * 1024;

DI unsigned f2bf(float f) { unsigned u = __builtin_bit_cast(unsigned, f); return (u + 0x7fffu + ((u >> 16) & 1u)) >> 16; }
DI unsigned pk2(float lo, float hi) { return f2bf(lo) | (f2bf(hi) << 16); }
DI float bf2f(unsigned short h) { return __builtin_bit_cast(float, (unsigned)h << 16); }
DI float bflo(unsigned w) { return __builtin_bit_cast(float, w << 16); }
DI float bfhi(unsigned w) { return __builtin_bit_cast(float, w & 0xffff0000u); }
DI float wave_sum(float v) {
#pragma unroll
    for (int o = 1; o < 64; o <<= 1) v += __shfl_xor(v, o);
    return v;
}
#define LDS_WAIT() asm volatile("s_waitcnt lgkmcnt(0)" ::: "memory")
#define XB_TMO      128
#define XB_XCNT(j)  (256  + 64 * (j))
#define XB_XSUB(j)  (1280 + 64 * (j))
#define XB_XGEN(j)  (2304 + 64 * (j))
#define XB_TOP      3328
#define XB_TOPGEN   3392
#define XCD_BAR_WORDS 3456
#define XB_SPIN_CAP (1u << 18)

__device__ __forceinline__ unsigned xb_ld(unsigned* p)              { return __hip_atomic_load(p, __ATOMIC_RELAXED, __HIP_MEMORY_SCOPE_AGENT); }
__device__ __forceinline__ unsigned xb_add(unsigned* p, unsigned v) { return __hip_atomic_fetch_add(p, v, __ATOMIC_RELAXED, __HIP_MEMORY_SCOPE_AGENT); }
__device__ __forceinline__ unsigned xb_xcc_id() { return (unsigned)__builtin_amdgcn_s_getreg((3 << 11) | 20) & 0xFu; }
#define XB_SPIN(cond, bar) do { unsigned _sp = 0; while (cond) { __builtin_amdgcn_s_sleep(1); \
    if ((++_sp & 255u) == 0u) { if (xb_ld(&(bar)[XB_TMO])) break; if (_sp > XB_SPIN_CAP) { atomicAdd(&(bar)[XB_TMO], 1u); break; } } } } while (0)

struct XcdBarrier {
    unsigned* bar; unsigned x;
    volatile LAS unsigned* st;
};

__device__ __forceinline__ XcdBarrier xcd_barrier_post(unsigned* bar, volatile LAS unsigned* st) {
    XcdBarrier b; b.bar = bar; b.x = xb_xcc_id(); b.st = st;
    if (threadIdx.x == 0) (void)xb_add(&bar[XB_XCNT(b.x)], 1u);
    return b;
}
__device__ __forceinline__ void xcd_barrier_complete(unsigned* bar, unsigned x, unsigned& nloc, unsigned& nx) {
    const unsigned G = gridDim.x * gridDim.y * gridDim.z;
    unsigned sum, cnt, mine, sp = 0u;
    for (;;) {
        sum = 0u; cnt = 0u; mine = 0u;
#pragma unroll
        for (unsigned j = 0; j < 16; ++j) { const unsigned c = xb_ld(&bar[XB_XCNT(j)]); sum += c; cnt += (c > 0u) ? 1u : 0u; mine = (j == x) ? c : mine; }
        if (sum == G) break;
        __builtin_amdgcn_s_sleep(1);
        if ((++sp & 255u) == 0u) { if (xb_ld(&bar[XB_TMO])) break; if (sp > XB_SPIN_CAP) { atomicAdd(&bar[XB_TMO], 1u); break; } }
    }
    nloc = mine > 0u ? mine : 1u; nx = cnt > 0u ? cnt : 1u;
}

__device__ __forceinline__ void xcd_barrier(const XcdBarrier& b) {
    asm volatile("s_waitcnt vmcnt(0)" ::: "memory");
    __syncthreads();
    if (threadIdx.x == 0) {
        unsigned* bar = b.bar;
        __builtin_amdgcn_s_waitcnt(0);
        unsigned nloc = b.st[0], nx = b.st[1];
        if (nloc == 0u) { xcd_barrier_complete(bar, b.x, nloc, nx); b.st[0] = nloc; b.st[1] = nx; }
        const unsigned old = xb_add(&bar[XB_XSUB(b.x)], 1u);
        const unsigned gen = old / nloc;
        if (old + 1u == (gen + 1u) * nloc) {
            __builtin_amdgcn_fence(__ATOMIC_RELEASE, "agent");
            asm volatile("s_waitcnt vmcnt(0)" ::: "memory");
            const unsigned og = xb_add(&bar[XB_TOP], 1u);
            const unsigned tg = og / nx;
            if (og + 1u == (tg + 1u) * nx) xb_add(&bar[XB_TOPGEN], 1u);
            else XB_SPIN(xb_ld(&bar[XB_TOPGEN]) == tg, bar);
            __builtin_amdgcn_fence(__ATOMIC_ACQUIRE, "agent");
            xb_add(&bar[XB_XGEN(b.x)], 1u);
            asm volatile("s_waitcnt vmcnt(0)" ::: "memory");
        } else {
            XB_SPIN(xb_ld(&bar[XB_XGEN(b.x)]) == gen, bar);
            __builtin_amdgcn_fence(__ATOMIC_ACQUIRE, "agent");
            asm volatile("s_waitcnt vmcnt(0)" ::: "memory");
        }
    }
    __syncthreads();
}

constexpr int TR_LD = 65;
DI void tr_item(const float* W, int ldw, int nvalid, int k0, int n0, bf16* WT, int K, int drow0, LAS float* scr, int lane) {
    const int nn = n0 + 4 * (lane & 15); const bool ok = nn < nvalid;
    f32x4 v[16];
#pragma unroll
    for (int i = 0; i < 16; ++i) { const int kk = 4 * i + (lane >> 4); v[i] = ok ? *(const f32x4*)(W + (size_t)(k0 + kk) * ldw + nn) : (f32x4){0.f, 0.f, 0.f, 0.f}; }
#pragma unroll
    for (int i = 0; i < 16; ++i) { const int kk = 4 * i + (lane >> 4); LAS float* d = scr + kk * TR_LD + 4 * (lane & 15); d[0] = v[i].x; d[1] = v[i].y; d[2] = v[i].z; d[3] = v[i].w; }
    LDS_WAIT(); asm volatile("" ::: "memory");
    const int c = lane & 7;
#pragma unroll
    for (int j = 0; j < 8; ++j) { const int n = (lane >> 3) + 8 * j; const LAS float* s = scr + (8 * c) * TR_LD + n;
        u32x4 o; o.x = pk2(s[0 * TR_LD], s[1 * TR_LD]); o.y = pk2(s[2 * TR_LD], s[3 * TR_LD]); o.z = pk2(s[4 * TR_LD], s[5 * TR_LD]); o.w = pk2(s[6 * TR_LD], s[7 * TR_LD]);
        *(u32x4*)(WT + (size_t)(drow0 + n) * K + k0 + 8 * c) = o; }
    LDS_WAIT(); asm volatile("" ::: "memory");
}
DI void tr_plain(const float* W, int K, int N, int Npad, bf16* WT, LAS float* scr, int r, int lane) {
    const int nblk = Npad / 64, kb = r / nblk, nb = r % nblk;
    tr_item(W, N, N, 64 * kb, 64 * nb, WT, K, 64 * nb, scr, lane);
}
DI void tr_gu(const float* W, int K, int N, int half, bf16* WT, LAS float* scr, int r, int lane) {
    const int nblk = N / 64, kb = r / nblk, nb = r % nblk, n0 = 64 * nb;
    tr_item(W, N, N, 64 * kb, n0, WT, K, (n0 >> 7) * 256 + (n0 & 127) + half * 128, scr, lane);
}
struct Ptrs {
    const float* in[20]; float* out; unsigned char* ws;
    int tid, lane, wave, bid, G;
};
DI void phase_convert_even(const Ptrs& P, LAS unsigned char* lds, int li) {
    LAS float* scr = (LAS float*)(lds + P.wave * 16640);
    const int gw = P.bid * NWAVES + P.wave, NGW = P.G * NWAVES;
    const float* w_in = P.in[1] + (size_t)li * DM * EV_N; const float* w_out = P.in[2] + (size_t)li * DM * DM;
    const float* w1 = P.in[5] + (size_t)li * DM * FF; const float* w3 = P.in[6] + (size_t)li * DM * FF; const float* w2 = P.in[7] + (size_t)li * FF * DM;
    bf16* WIN = (bf16*)(P.ws + WS_WIN); bf16* WOUT = (bf16*)(P.ws + WS_WOUT); bf16* WUP = (bf16*)(P.ws + WS_WUP); bf16* WDN = (bf16*)(P.ws + WS_WDN);
    constexpr int I_IN = (DM / 64) * (EV_NP / 64), I_OUT = (DM / 64) * (DM / 64), I_GU = (DM / 64) * (FF / 64), I_DN = (FF / 64) * (DM / 64);
    constexpr int NIT = I_IN + I_OUT + 2 * I_GU + I_DN;
    for (int it = gw; it < NIT; it += NGW) {
        int r = it;
        if (r < I_IN) { tr_plain(w_in, DM, EV_N, EV_NP, WIN, scr, r, P.lane); continue; } r -= I_IN;
        if (r < I_OUT) { tr_plain(w_out, DM, DM, DM, WOUT, scr, r, P.lane); continue; } r -= I_OUT;
        if (r < I_GU) { tr_gu(w1, DM, FF, 0, WUP, scr, r, P.lane); continue; } r -= I_GU;
        if (r < I_GU) { tr_gu(w3, DM, FF, 1, WUP, scr, r, P.lane); continue; } r -= I_GU;
        tr_plain(w2, FF, DM, DM, WDN, scr, r, P.lane);
    }
}
DI void phase_convert_odd(const Ptrs& P, LAS unsigned char* lds, int li) {
    LAS float* scr = (LAS float*)(lds + P.wave * 16640);
    const int gw = P.bid * NWAVES + P.wave, NGW = P.G * NWAVES;
    const float* w_in = P.in[10] + (size_t)li * DM * OD_N; const float* w_out = P.in[11] + (size_t)li * DM * DM;
    const float* w1 = P.in[15] + (size_t)li * NEXP * DM * FFE; const float* w3 = P.in[16] + (size_t)li * NEXP * DM * FFE; const float* w2 = P.in[17] + (size_t)li * NEXP * FFE * DM;
    bf16* WIN = (bf16*)(P.ws + WS_WIN); bf16* WOUT = (bf16*)(P.ws + WS_WOUT); bf16* WUP = (bf16*)(P.ws + WS_WUP); bf16* WDN = (bf16*)(P.ws + WS_WDN);
    constexpr int I_IN = (DM / 64) * (OD_N / 64), I_OUT = (DM / 64) * (DM / 64), I_GU = (DM / 64) * (FFE / 64), I_DN = (FFE / 64) * (DM / 64);
    constexpr int NIT = I_IN + I_OUT + NEXP * (2 * I_GU + I_DN);
    for (int it = gw; it < NIT; it += NGW) {
        int r = it;
        if (r < I_IN) { tr_plain(w_in, DM, OD_N, OD_N, WIN, scr, r, P.lane); continue; } r -= I_IN;
        if (r < I_OUT) { tr_plain(w_out, DM, DM, DM, WOUT, scr, r, P.lane); continue; } r -= I_OUT;
        const int e = r / (2 * I_GU + I_DN); r -= e * (2 * I_GU + I_DN);
        if (r < I_GU) { tr_gu(w1 + (size_t)e * DM * FFE, DM, FFE, 0, WUP + (size_t)e * 2 * FFE * DM, scr, r, P.lane); continue; } r -= I_GU;
        if (r < I_GU) { tr_gu(w3 + (size_t)e * DM * FFE, DM, FFE, 1, WUP + (size_t)e * 2 * FFE * DM, scr, r, P.lane); continue; } r -= I_GU;
        tr_plain(w2 + (size_t)e * FFE * DM, FFE, DM, DM, WDN + (size_t)e * DM * FFE, scr, r, P.lane);
    }
}
DI void phase_init(const Ptrs& P) {
    const int gw = P.bid * NWAVES + P.wave, NGW = P.G * NWAVES;
    const float* x = P.in[0]; bf16* XB = (bf16*)(P.ws + WS_XB);
    for (int m = gw; m < NTOK; m += NGW) {
        const f32x4* xr = (const f32x4*)(x + (size_t)m * DM) + P.lane; u32x2* o = (u32x2*)(XB + (size_t)m * DM) + P.lane;
#pragma unroll
        for (int j = 0; j < 4; ++j) { const f32x4 v = xr[64 * j]; u32x2 w; w.x = pk2(v.x, v.y); w.y = pk2(v.z, v.w); o[64 * j] = w; }
    }
    float* c64 = (float*)(P.ws + WS_TAB + TB_COS64); float* s64 = (float*)(P.ws + WS_TAB + TB_SIN64);
    float* c32 = (float*)(P.ws + WS_TAB + TB_COS32); float* s32 = (float*)(P.ws + WS_TAB + TB_SIN32);
    const int gt = P.bid * NTHR + P.tid, NGT = P.G * NTHR;
    for (int i = gt; i < SEQ * 32; i += NGT) { const int pos = i >> 5, j = i & 31; const float inv = exp2f(-(float)j * (13.287712379549449f / 32.0f)); const float a = (float)pos * inv; const double rv = (double)a * 0.15915494309189535; const float fr = (float)(rv - floor(rv)); c64[i] = __builtin_amdgcn_cosf(fr); s64[i] = __builtin_amdgcn_sinf(fr); }
    for (int i = gt; i < SEQ * 16; i += NGT) { const int pos = i >> 4, j = i & 15; const float inv = exp2f(-(float)j * (13.287712379549449f / 16.0f)); const float a = (float)pos * inv; const double rv = (double)a * 0.15915494309189535; const float fr = (float)(rv - floor(rv)); c32[i] = __builtin_amdgcn_cosf(fr); s32[i] = __builtin_amdgcn_sinf(fr); }
}

DI void rope_item(bf16* p, int half, float scale, const float* ct, const float* st) {
    const u32x2 a = *(const u32x2*)p, b = *(const u32x2*)(p + half);
    const f32x4 c = *(const f32x4*)ct, s = *(const f32x4*)st;
    const f32x4 x1 = {bflo(a.x), bfhi(a.x), bflo(a.y), bfhi(a.y)}, x2 = {bflo(b.x), bfhi(b.x), bflo(b.y), bfhi(b.y)};
    const f32x4 o1 = (x1 * c - x2 * s) * scale, o2 = (x1 * s + x2 * c) * scale;
    u32x2 wa, wb; wa.x = pk2(o1.x, o1.y); wa.y = pk2(o1.z, o1.w); wb.x = pk2(o2.x, o2.y); wb.y = pk2(o2.z, o2.w);
    *(u32x2*)p = wa; *(u32x2*)(p + half) = wb;
}
DI void phase_rope_even(const Ptrs& P) {
    const int gw = P.bid * NWAVES + P.wave, NGW = P.G * NWAVES;
    bf16* PROJ = (bf16*)(P.ws + WS_R1);
    const float* c64 = (const float*)(P.ws + WS_TAB + TB_COS64); const float* s64 = (const float*)(P.ws + WS_TAB + TB_SIN64);
    const float* c32 = (const float*)(P.ws + WS_TAB + TB_COS32); const float* s32 = (const float*)(P.ws + WS_TAB + TB_SIN32);
    for (int m = gw; m < NTOK; m += NGW) {
        const int pos = m & (SEQ - 1); bf16* row = PROJ + (size_t)m * EV_NP;
        for (int id = P.lane; id < 236; id += 64) {
            int col, jj, half = 32; float sc = 1.f;
            if (id < 64) { col = C_QA + (id >> 3) * 64; jj = (id & 7) * 4; sc = QSCALE; }
            else if (id < 72) { col = C_KA; jj = (id - 64) * 4; }
            else if (id < 104) { const int k = id - 72; col = C_IQ + (k >> 2) * 32; jj = (k & 3) * 4; half = 16; }
            else if (id < 108) { col = C_IK; jj = (id - 104) * 4; half = 16; }
            else if (id < 172) { const int k = id - 108; col = C_QB + (k >> 3) * 64; jj = (k & 7) * 4; sc = QSCALE; }
            else { const int k = id - 172; col = C_KB + (k >> 3) * 64; jj = (k & 7) * 4; }
            const float* ct = (half == 32) ? c64 + pos * 32 + jj : c32 + pos * 16 + jj;
            const float* st = (half == 32) ? s64 + pos * 32 + jj : s32 + pos * 16 + jj;
            rope_item(row + col + jj, half, sc, ct, st);
        }
    }
}
DI void phase_rope_odd(const Ptrs& P) {
    const int gw = P.bid * NWAVES + P.wave, NGW = P.G * NWAVES;
    bf16* PROJ = (bf16*)(P.ws + WS_R1);
    const float* c64 = (const float*)(P.ws + WS_TAB + TB_COS64); const float* s64 = (const float*)(P.ws + WS_TAB + TB_SIN64);
    for (int m = gw; m < NTOK; m += NGW) {
        const int pos = m & (SEQ - 1); bf16* row = PROJ + (size_t)m * OD_N;
#pragma unroll
        for (int r = 0; r < 4; ++r) { const int id = P.lane + 64 * r;
            const int k = id & 127, col = (id < 128 ? OC_Q : OC_K) + (k >> 3) * 64, jj = (k & 7) * 4;
            rope_item(row + col + jj, 32, id < 128 ? QSCALE : 1.f, c64 + pos * 32 + jj, s64 + pos * 32 + jj); }
    }
}

DI void ln_core(f32x4 (&v)[4], const float* g, const float* b, int lane) {
    float s = 0.f;
#pragma unroll
    for (int j = 0; j < 4; ++j) s += (v[j].x + v[j].y) + (v[j].z + v[j].w);
    const float mean = wave_sum(s) * (1.f / DM); float s2 = 0.f;
#pragma unroll
    for (int j = 0; j < 4; ++j) { v[j] = v[j] - mean; s2 += (v[j].x * v[j].x + v[j].y * v[j].y) + (v[j].z * v[j].z + v[j].w * v[j].w); }
    const float rstd = 1.f / sqrtf(wave_sum(s2) * (1.f / DM) + LN_EPS);
#pragma unroll
    for (int j = 0; j < 4; ++j) { const f32x4 gg = ((const f32x4*)g)[64 * j + lane], bb = ((const f32x4*)b)[64 * j + lane]; v[j] = v[j] * rstd * gg + bb; }
}
DI void ln_store(const f32x4 (&v)[4], float* xf, bf16* xb, int lane) {
#pragma unroll
    for (int j = 0; j < 4; ++j) { ((f32x4*)xf)[64 * j + lane] = v[j]; if (xb) { u32x2 w; w.x = pk2(v[j].x, v[j].y); w.y = pk2(v[j].z, v[j].w); ((u32x2*)xb)[64 * j + lane] = w; } }
}
template <bool ROUTER> DI void phase_ln(const Ptrs& P, LAS unsigned char* lds, const float* g, const float* b, float* xf_out, bf16* xb_out, const float* router) {
    const int gw = P.bid * NWAVES + P.wave, NGW = P.G * NWAVES;
    const float* MIX = (const float*)(P.ws + WS_MIX);
    LAS float* rl = (LAS float*)lds;
    if (ROUTER) { for (int i = P.tid; i < DM * NEXP / 4; i += NTHR) ((LAS f32x4*)rl)[i] = ((const f32x4*)router)[i]; __syncthreads(); }
    int* eid = (int*)(P.ws + WS_MISC + MS_EID); float* gate = (float*)(P.ws + WS_MISC + MS_GATE);
    for (int m = gw; m < NTOK; m += NGW) {
        f32x4 v[4];
#pragma unroll
        for (int j = 0; j < 4; ++j) v[j] = ((const f32x4*)(MIX + (size_t)m * DM))[64 * j + P.lane];
        ln_core(v, g, b, P.lane);
        ln_store(v, xf_out + (size_t)m * DM, xb_out ? xb_out + (size_t)m * DM : nullptr, P.lane);
        if (ROUTER) {
            float lg[8];
#pragma unroll
            for (int e = 0; e < 8; ++e) lg[e] = 0.f;
#pragma unroll
            for (int j = 0; j < 4; ++j)
#pragma unroll
                for (int c = 0; c < 4; ++c) { const int col = 4 * (64 * j + P.lane) + c; const f32x4 r0 = *(const LAS f32x4*)(rl + col * 8), r1 = *(const LAS f32x4*)(rl + col * 8 + 4); const float x = v[j][c];
                    lg[0] += x * r0.x; lg[1] += x * r0.y; lg[2] += x * r0.z; lg[3] += x * r0.w; lg[4] += x * r1.x; lg[5] += x * r1.y; lg[6] += x * r1.z; lg[7] += x * r1.w; }
#pragma unroll
            for (int e = 0; e < 8; ++e) lg[e] = wave_sum(lg[e]);
            int i1 = 0; float v1 = lg[0];
#pragma unroll
            for (int e = 1; e < 8; ++e) if (lg[e] > v1) { v1 = lg[e]; i1 = e; }
            int i2 = -1; float v2 = -INFINITY;
#pragma unroll
            for (int e = 0; e < 8; ++e) if (e != i1 && lg[e] > v2) { v2 = lg[e]; i2 = e; }
            const float ex = expf(v2 - v1), g1 = 1.f / (1.f + ex), g2 = ex / (1.f + ex);
            if (P.lane == 0) { eid[2 * m] = i1; eid[2 * m + 1] = i2; gate[2 * m] = g1; gate[2 * m + 1] = g2; }
        }
    }
}

DI void phase_route(const Ptrs& P, LAS unsigned char* lds) {
    const int* eid = (const int*)(P.ws + WS_MISC + MS_EID);
    int* rowof = (int*)(P.ws + WS_MISC + MS_ROWOF); int* pblk = (int*)(P.ws + WS_MISC + MS_PBLK);
    const bf16* XB = (const bf16*)(P.ws + WS_XB); bf16* XBUF = (bf16*)(P.ws + WS_XBUF);
    LAS int* cl = (LAS int*)lds;
    for (int c = P.bid; c < NTOK / 64; c += P.G) {
        __syncthreads();
        if (P.tid < 32) cl[P.tid] = 0;
        __syncthreads();
        int tot[8], bef[8];
#pragma unroll
        for (int e = 0; e < 8; ++e) { tot[e] = 0; bef[e] = 0; }
        const int a0 = 128 * c;
        for (int k = 0; k < 64; ++k) { const int a = P.tid + NTHR * k; const int e = eid[a]; const int pre = (a < a0) ? 1 : 0;
#pragma unroll
            for (int x = 0; x < 8; ++x) { const int hit = (e == x) ? 1 : 0; tot[x] += hit; bef[x] += hit & pre; } }
#pragma unroll
        for (int x = 0; x < 8; ++x) {
            int t = tot[x], q = bef[x];
#pragma unroll
            for (int o = 1; o < 64; o <<= 1) { t += __shfl_xor(t, o); q += __shfl_xor(q, o); }
            if (P.lane == 0) { __hip_atomic_fetch_add(&cl[x], t, __ATOMIC_RELAXED, __HIP_MEMORY_SCOPE_WORKGROUP); __hip_atomic_fetch_add(&cl[8 + x], q, __ATOMIC_RELAXED, __HIP_MEMORY_SCOPE_WORKGROUP); }
        }
        __syncthreads();
        if (P.tid == 0) { int acc = 0; for (int e = 0; e < 8; ++e) { cl[16 + e] = acc; acc += (cl[e] + 255) >> 8; } cl[24] = acc; }
        __syncthreads();
        if (P.wave == 0) {
            int run[8];
#pragma unroll
            for (int x = 0; x < 8; ++x) run[x] = 0;
            const unsigned long long lt = (P.lane == 0) ? 0ull : (~0ull >> (64 - P.lane));
#pragma unroll
            for (int h = 0; h < 2; ++h) { const int i = 64 * h + P.lane; const int e = eid[a0 + i]; int dest = 0;
#pragma unroll
                for (int x = 0; x < 8; ++x) { const unsigned long long mk = __ballot(e == x); if (e == x) dest = 256 * cl[16 + x] + cl[8 + x] + run[x] + __builtin_popcountll(mk & lt); run[x] += __builtin_popcountll(mk); }
                cl[32 + i] = dest; rowof[a0 + i] = dest; }
        }
        if (c == 0 && P.tid < 9) pblk[P.tid] = cl[16 + P.tid];
        __syncthreads();
        for (int i = P.wave; i < 128; i += NWAVES) { const int dest = cl[32 + i]; const int t = (a0 + i) >> 1;
            const u32x4* s = (const u32x4*)(XB + (size_t)t * DM) + 2 * P.lane; u32x4* d = (u32x4*)(XBUF + (size_t)dest * DM) + 2 * P.lane;
            const u32x4 v0 = s[0], v1 = s[1]; d[0] = v0; d[1] = v1; }
    }
}
DI void phase_moe_combine(const Ptrs& P, const float* g, const float* b, float* xf_out, bf16* xb_out) {
    const int gw = P.bid * NWAVES + P.wave, NGW = P.G * NWAVES;
    const float* XF = (const float*)(P.ws + WS_XF); const float* Y = (const float*)(P.ws + WS_MIX);
    const int* rowof = (const int*)(P.ws + WS_MISC + MS_ROWOF); const float* gate = (const float*)(P.ws + WS_MISC + MS_GATE);
    for (int m = gw; m < NTOK; m += NGW) {
        const int r0 = rowof[2 * m], r1 = rowof[2 * m + 1]; const float g0 = gate[2 * m], g1 = gate[2 * m + 1];
        f32x4 v[4];
#pragma unroll
        for (int j = 0; j < 4; ++j) { const f32x4 x = ((const f32x4*)(XF + (size_t)m * DM))[64 * j + P.lane], y0 = ((const f32x4*)(Y + (size_t)r0 * DM))[64 * j + P.lane], y1 = ((const f32x4*)(Y + (size_t)r1 * DM))[64 * j + P.lane];
            v[j] = ALPHA * x + (g0 * y0 + g1 * y1); }
        ln_core(v, g, b, P.lane);
        ln_store(v, xf_out + (size_t)m * DM, xb_out ? xb_out + (size_t)m * DM : nullptr, P.lane);
    }
}

constexpr int SC_LD = 2052;
DI unsigned fkey(float f) { const unsigned u = __builtin_bit_cast(unsigned, f); return (u & 0x80000000u) ? ~u : (u | 0x80000000u); }
DI int wave_sum_i(int v) {
    v += __builtin_amdgcn_update_dpp(0, v, 0xB1, 0xf, 0xf, true);
    v += __builtin_amdgcn_update_dpp(0, v, 0x4E, 0xf, 0xf, true);
    v += __builtin_amdgcn_update_dpp(0, v, 0x141, 0xf, 0xf, true);
    v += __builtin_amdgcn_update_dpp(0, v, 0x140, 0xf, 0xf, true);
    return __builtin_amdgcn_readlane(v, 0) + __builtin_amdgcn_readlane(v, 16) + __builtin_amdgcn_readlane(v, 32) + __builtin_amdgcn_readlane(v, 48);
}
DI void idx_unit(const Ptrs& P, LAS unsigned char* lds, int b, int qb16) {
    const bf16* PROJ = (const bf16*)(P.ws + WS_R1); unsigned* MASK = (unsigned*)(P.ws + WS_MASK);
    LAS float* sc = (LAS float*)lds;
    const int t0 = 16 * qb16, lane = P.lane, l15 = lane & 15, l4 = lane >> 4; const size_t rowbase = (size_t)b * SEQ;
    __syncthreads();
    {
        const bf16* qrow = PROJ + (rowbase + t0 + l15) * EV_NP;
        const int nkt = qb16 + 1;
        bf16x8 ak[16];
#pragma unroll
        for (int i = 0; i < 16; ++i) { const int kt = P.wave + 8 * i; const int ktc = kt < nkt ? kt : nkt - 1; ak[i] = *(const bf16x8*)(PROJ + (rowbase + 16 * ktc + l15) * EV_NP + C_IK + 8 * l4); }
        bf16x8 bq[8];
#pragma unroll
        for (int h = 0; h < 8; ++h) bq[h] = *(const bf16x8*)(qrow + C_IQ + h * 32 + 8 * l4);
        const u32x4 wraw = *(const u32x4*)(qrow + C_IW); float wv[8];
        const float WS = 0.17677669529663687f * 0.35355339059327373f;
        wv[0] = bflo(wraw.x) * WS; wv[1] = bfhi(wraw.x) * WS; wv[2] = bflo(wraw.y) * WS; wv[3] = bfhi(wraw.y) * WS; wv[4] = bflo(wraw.z) * WS; wv[5] = bfhi(wraw.z) * WS; wv[6] = bflo(wraw.w) * WS; wv[7] = bfhi(wraw.w) * WS;
#pragma unroll
        for (int i = 0; i < 16; ++i) { const int kt = P.wave + 8 * i;
            if (kt < nkt) {
                f32x4 s = {0.f, 0.f, 0.f, 0.f};
#pragma unroll
                for (int h = 0; h < 8; ++h) { const f32x4 z = {0.f, 0.f, 0.f, 0.f}; const f32x4 d = __builtin_amdgcn_mfma_f32_16x16x32_bf16(ak[i], bq[h], z, 0, 0, 0);
                    s.x += wv[h] * fmaxf(d.x, 0.f); s.y += wv[h] * fmaxf(d.y, 0.f); s.z += wv[h] * fmaxf(d.z, 0.f); s.w += wv[h] * fmaxf(d.w, 0.f); }
                if (kt == nkt - 1) { const int kq = 4 * l4; if (kq + 0 > l15) s.x = -INFINITY; if (kq + 1 > l15) s.y = -INFINITY; if (kq + 2 > l15) s.z = -INFINITY; if (kq + 3 > l15) s.w = -INFINITY; }
                *(LAS f32x4*)(sc + l15 * SC_LD + 16 * kt + 4 * l4) = s;
            } }
    }
    __syncthreads();
    const unsigned long long ltm = (lane == 0) ? 0ull : (~0ull >> (64 - lane));
    for (int rr = 0; rr < 2; ++rr) {
        const int r = 2 * P.wave + rr, t = t0 + r; const int jmax = (t >> 6) + 1;
        unsigned key[32];
#pragma unroll
        for (int j = 0; j < 32; ++j) { const int idx = 64 * j + lane; const float f = sc[r * SC_LD + idx]; key[j] = (idx <= t) ? fkey(f) : 0u; }
        unsigned T = 0u; int need = 0; bool plain = true;
        const bool all = (t + 1 <= 256);
        if (!all) {
            for (int bit = 31; bit >= 0; --bit) { const unsigned cand = T | (1u << bit); int c = 0;
#pragma unroll
                for (int j = 0; j < 32; ++j) c += (key[j] >= cand) ? 1 : 0;
                if (wave_sum_i(c) >= 256) T = cand; }
            int cg = 0, ce = 0;
#pragma unroll
            for (int j = 0; j < 32; ++j) { cg += (key[j] > T) ? 1 : 0; ce += (key[j] == T) ? 1 : 0; }
            const int ngt = wave_sum_i(cg), neq = wave_sum_i(ce);
            need = 256 - ngt; plain = (neq == need);
        } else T = 1u;
        unsigned myw = 0u;
        if (plain) {
#pragma unroll
            for (int j = 0; j < 32; ++j) { const unsigned long long sm = __ballot(key[j] >= T);
                if (lane == 2 * j) myw = (unsigned)sm;
                if (lane == 2 * j + 1) myw = (unsigned)(sm >> 32);
                __builtin_amdgcn_sched_barrier(0); }
        } else {
            int run = 0;
#pragma unroll
            for (int j = 0; j < 32; ++j) { const bool eq = key[j] == T; const unsigned long long em = __ballot(eq); const int rank = run + __builtin_popcountll(em & ltm);
                const unsigned long long sm = __ballot(key[j] > T || (eq && rank < need)); run += __builtin_popcountll(em);
                if (lane == 2 * j) myw = (unsigned)sm;
                if (lane == 2 * j + 1) myw = (unsigned)(sm >> 32);
                __builtin_amdgcn_sched_barrier(0); }
        }
        MASK[(rowbase + t) * 64 + lane] = myw;
    }
}
DI void kmean_unit(const Ptrs& P, int b, int n) {
    const bf16* PROJ = (const bf16*)(P.ws + WS_R1); bf16* KM = (bf16*)(P.ws + WS_MISC + MS_KM);
    const int col = P.tid; const bf16* p = PROJ + ((size_t)b * SEQ + 256 * n) * EV_NP + C_KB + col; float s = 0.f;
#pragma unroll 8
    for (int r = 0; r < 256; ++r) s += bf2f(p[(size_t)r * EV_NP]);
    KM[(((size_t)b * 8 + (col >> 6)) * 8 + n) * 64 + (col & 63)] = (bf16)f2bf(s * (1.f / 256.f));
}
DI void phase_index(const Ptrs& P, LAS unsigned char* lds) {
    for (int u = P.bid; u < 64; u += P.G) kmean_unit(P, u & 7, u >> 3);
    for (int k = 0; ; ++k) { const int u = P.bid + P.G * k; if (u >= 1024) break;
        const int b = u & 7, v = u >> 3, kq = v >> 5, a = v & 31; const int idx = (kq == 0) ? a : (kq == 1) ? 127 - a : (kq == 2) ? 32 + a : 95 - a;
        idx_unit(P, lds, b, idx); }
}

constexpr int KROW = 144;
constexpr float M_INIT = -1.0e30f;
DI f32x16 mfma32(bf16x8 a, bf16x8 b, f32x16 c) { return __builtin_amdgcn_mfma_f32_32x32x16_bf16(a, b, c, 0, 0, 0); }
typedef short v4i16_t __attribute__((ext_vector_type(4)));
DI s16x4 vtr(const LAS unsigned char* p) { return __builtin_bit_cast(s16x4, __builtin_amdgcn_ds_read_tr16_b64_v4i16((LAS v4i16_t*)p)); }
typedef __bf16 bf16x2_t __attribute__((ext_vector_type(2)));
DI unsigned cvtpk(float lo, float hi) { const f32x2 v = {lo, hi}; const bf16x2_t b = __builtin_convertvector(v, bf16x2_t); return __builtin_bit_cast(unsigned, b); }
DI void swap32(unsigned& a, unsigned& b) { asm volatile("s_nop 1\n\tv_permlane32_swap_b32 %0, %1\n\ts_nop 1" : "+v"(a), "+v"(b)); }
DI float xhalf_max(float m) { unsigned a = __builtin_bit_cast(unsigned, m), b = a; swap32(a, b); return fmaxf(__builtin_bit_cast(float, a), __builtin_bit_cast(float, b)); }
DI float xhalf_sum(float m) { unsigned a = __builtin_bit_cast(unsigned, m), b = a; swap32(a, b); return __builtin_bit_cast(float, a) + __builtin_bit_cast(float, b); }
DI int crow(int r, int hi) { return (r & 3) + 8 * (r >> 2) + 4 * hi; }

struct AState { float m, l; f32x16 o0, o1; };
DI void astate_init(AState& s) { s.m = M_INIT; s.l = 0.f;
#pragma unroll
    for (int r = 0; r < 16; ++r) { s.o0[r] = 0.f; s.o1[r] = 0.f; } }

template <class MaskF>
DI void attn_tile(AState& st, const LAS unsigned char* kt, const LAS unsigned char* vt, int vd0, const bf16x8 (&qr)[4], LAS float* wsf, int lane, MaskF&& mask) {
    const int r32 = lane & 31, hi = lane >> 5;
    f32x16 p0, p1;
#pragma unroll
    for (int r = 0; r < 16; ++r) { p0[r] = 0.f; p1[r] = 0.f; }
    const LAS unsigned char* kb = kt + r32 * KROW + hi * 16;
#pragma unroll
    for (int d0 = 0; d0 < 4; ++d0) { const bf16x8 a0 = *(const LAS bf16x8*)(kb + d0 * 32), a1 = *(const LAS bf16x8*)(kb + 32 * KROW + d0 * 32);
        p0 = mfma32(a0, qr[d0], p0); p1 = mfma32(a1, qr[d0], p1); }
    mask(p0, p1);
    float rm = fmaxf(p0[0], p1[0]);
#pragma unroll
    for (int r = 1; r < 16; ++r) rm = fmaxf(rm, fmaxf(p0[r], p1[r]));
    rm = xhalf_max(rm);
    if (__any(rm > st.m)) {
        const float mn = fmaxf(st.m, rm), al = __builtin_amdgcn_exp2f(st.m - mn); st.l *= al; st.m = mn;
        if (hi == 0) wsf[r32] = al;
        asm volatile("s_waitcnt lgkmcnt(0)" ::: "memory");
#pragma unroll
        for (int g = 0; g < 4; ++g) { const f32x4 a4 = *(const LAS f32x4*)(wsf + 8 * g + 4 * hi);
#pragma unroll
            for (int i = 0; i < 4; ++i) { st.o0[4 * g + i] *= a4[i]; st.o1[4 * g + i] *= a4[i]; } }
    }
    float sacc = 0.f;
#pragma unroll
    for (int r = 0; r < 16; ++r) { p0[r] = __builtin_amdgcn_exp2f(p0[r] - st.m); p1[r] = __builtin_amdgcn_exp2f(p1[r] - st.m); sacc += p0[r] + p1[r]; }
    st.l += sacc;
    const LAS unsigned char* vb = vt + (4 * hi + ((lane & 15) >> 2)) * 64 + ((lane >> 4) & 1) * 32 + (lane & 3) * 8;
#pragma unroll
    for (int sub = 0; sub < 2; ++sub)
#pragma unroll
        for (int ks = 0; ks < 2; ++ks) {
            u32x4 pw;
            if (sub == 0) { pw.x = cvtpk(p0[8 * ks], p0[8 * ks + 1]); pw.y = cvtpk(p0[8 * ks + 2], p0[8 * ks + 3]); pw.z = cvtpk(p0[8 * ks + 4], p0[8 * ks + 5]); pw.w = cvtpk(p0[8 * ks + 6], p0[8 * ks + 7]); }
            else          { pw.x = cvtpk(p1[8 * ks], p1[8 * ks + 1]); pw.y = cvtpk(p1[8 * ks + 2], p1[8 * ks + 3]); pw.z = cvtpk(p1[8 * ks + 4], p1[8 * ks + 5]); pw.w = cvtpk(p1[8 * ks + 6], p1[8 * ks + 7]); }
            const bf16x8 pa = __builtin_bit_cast(bf16x8, pw);
            const LAS unsigned char* vr = vb + (32 * sub + 16 * ks) * 64;
            { const s16x4 lo = vtr(vr), hh = vtr(vr + 8 * 64); const bf16x8 vf = {lo[0], lo[1], lo[2], lo[3], hh[0], hh[1], hh[2], hh[3]}; st.o0 = mfma32(pa, vf, st.o0); }
            { const s16x4 lo = vtr(vr + vd0), hh = vtr(vr + vd0 + 8 * 64); const bf16x8 vf = {lo[0], lo[1], lo[2], lo[3], hh[0], hh[1], hh[2], hh[3]}; st.o1 = mfma32(pa, vf, st.o1); }
        }
}
template <class RowF>
DI float attn_finish(AState& st, LAS float* wsf, int lane, RowF&& rowp) {
    const int r32 = lane & 31, hi = lane >> 5;
    const float lt = xhalf_sum(st.l);
    if (hi == 0) wsf[32 + r32] = lt;
    asm volatile("s_waitcnt lgkmcnt(0)" ::: "memory");
#pragma unroll
    for (int g = 0; g < 4; ++g) { const f32x4 l4 = *(const LAS f32x4*)(wsf + 32 + 8 * g + 4 * hi);
#pragma unroll
        for (int i = 0; i < 4; ++i) { const float inv = 1.0f / l4[i]; bf16* o = rowp(8 * g + 4 * hi + i);
#ifdef DBG_L
            { const float L = l4[i]; const float a0 = st.o0[4 * g + i], a1 = st.o1[4 * g + i]; const bool obad = !(fabsf(a0) < 1e30f) || !(fabsf(a1) < 1e30f);
              const float c = (L == 0.f) ? 32.f : (L != L) ? 512.f : (fabsf(L) > 1e30f) ? 128.f : (L < 0.99f) ? 2048.f : obad ? 8192.f : 0.f; o[r32] = (bf16)f2bf(c); o[32 + r32] = (bf16)f2bf(c); }
#else
            o[r32] = (bf16)f2bf(st.o0[4 * g + i] * inv); o[32 + r32] = (bf16)f2bf(st.o1[4 * g + i] * inv);
#endif
            } }
    return lt;
}
struct TileRegs { u32x4 k, v; };
DI void tile_load(TileRegs& r, const bf16* krow, const bf16* vrow, int chunk) { r.k = *(const u32x4*)(krow + chunk * 8); r.v = *(const u32x4*)(vrow + chunk * 8); }
DI void tile_store(LAS unsigned char* kt, LAS unsigned char* vt, int vd0, const TileRegs& r, int key, int chunk) {
    *(LAS u32x4*)(kt + key * KROW + chunk * 16) = r.k;
    *(LAS u32x4*)(vt + (chunk >> 2) * vd0 + key * 64 + (chunk & 3) * 16) = r.v;
}
constexpr int AT_K = 64 * KROW, AT_V = 2 * 64 * 64, AT_BUF = AT_K + AT_V;
constexpr int AT_WSF = 2 * AT_BUF;
constexpr int AT_EXTRA = AT_WSF + NWAVES * 256;
DI void load_q(bf16x8 (&qr)[4], const bf16* qrowp  , int hi) {
#pragma unroll
    for (int d0 = 0; d0 < 4; ++d0) qr[d0] = *(const bf16x8*)(qrowp + d0 * 16 + hi * 8);
}
template <class KV, class Act, class MaskT>
DI void attn_run(AState& st, LAS unsigned char* lds, const bf16x8 (&qr)[4], int nt, int tid, int lane, int wave, KV&& kv, Act&& act, MaskT&& mask) {
    const int key = tid >> 3, chunk = tid & 7;
    LAS unsigned char* buf0 = lds; LAS unsigned char* buf1 = lds + AT_BUF; LAS float* wsf = (LAS float*)(lds + AT_WSF) + wave * 64;
    TileRegs tr; const bf16* kp; const bf16* vp;
    kv(0, key, kp, vp); tile_load(tr, kp, vp, chunk); tile_store(buf0, buf0 + AT_K, 4096, tr, key, chunk);
    __syncthreads();
    for (int t = 0; t < nt; ++t) {
        LAS unsigned char* cur = (t & 1) ? buf1 : buf0; LAS unsigned char* nxt = (t & 1) ? buf0 : buf1;
        const bool more = t + 1 < nt;
        if (more) { kv(t + 1, key, kp, vp); tile_load(tr, kp, vp, chunk); }
        if (act(t)) attn_tile(st, cur, cur + AT_K, 4096, qr, wsf, lane, [&](f32x16& p0, f32x16& p1) { mask(t, p0, p1); });
        if (more) tile_store(nxt, nxt + AT_K, 4096, tr, key, chunk);
        __syncthreads();
    }
}
#define CR(r) (((r) & 3) + 8 * ((r) >> 2))
DI void dsa_unit(const Ptrs& P, LAS unsigned char* lds, int b, int qb32) {
    const bf16* PROJ = (const bf16*)(P.ws + WS_R1); const unsigned* MASK = (const unsigned*)(P.ws + WS_MASK); bf16* O = (bf16*)(P.ws + WS_O);
    const int lane = P.lane, r32 = lane & 31, hi = lane >> 5, t0 = 32 * qb32; const size_t rowbase = (size_t)b * SEQ;
    LAS unsigned* ml = (LAS unsigned*)(lds + AT_EXTRA);
#pragma unroll
    for (int k = 0; k < 4; ++k) { const int idx = P.tid + NTHR * k, row = idx >> 6, j = idx & 63; ml[j * 33 + row] = MASK[(rowbase + t0 + row) * 64 + j]; }
    bf16x8 qr[4]; load_q(qr, PROJ + (rowbase + t0 + r32) * EV_NP + C_QA + P.wave * 64, hi);
    AState st; astate_init(st);
    const int nt = (t0 + 32 + 63) >> 6;
    attn_run(st, lds, qr, nt, P.tid, lane, P.wave,
        [&](int t, int key, const bf16*& kp, const bf16*& vp) { const bf16* rp = PROJ + (rowbase + 64 * t + key) * EV_NP; kp = rp + C_KA; vp = rp + C_VA; },
        [&](int) { return true; },
        [&](int t, f32x16& p0, f32x16& p1) { const unsigned w0 = ml[(2 * t) * 33 + r32] >> (4 * hi), w1 = ml[(2 * t + 1) * 33 + r32] >> (4 * hi);
#pragma unroll
            for (int r = 0; r < 16; ++r) { if (!((w0 >> CR(r)) & 1u)) p0[r] = -INFINITY; if (!((w1 >> CR(r)) & 1u)) p1[r] = -INFINITY; } });
    LAS float* wsf = (LAS float*)(lds + AT_WSF) + P.wave * 64;
    (void)attn_finish(st, wsf, lane, [&](int rr) { return O + (rowbase + t0 + rr) * DM + P.wave * 64; });
}
DI void moba_unit(const Ptrs& P, LAS unsigned char* lds, int b, int h, int n) {
    const bf16* PROJ = (const bf16*)(P.ws + WS_R1); const bf16* KM = (const bf16*)(P.ws + WS_MISC + MS_KM); bf16* O = (bf16*)(P.ws + WS_O);
    const int lane = P.lane, r32 = lane & 31, hi = lane >> 5; const size_t rowbase = (size_t)b * SEQ; const int q0 = 256 * n + 32 * P.wave;
    bf16x8 qr[4]; load_q(qr, PROJ + (rowbase + q0 + r32) * EV_NP + C_QB + h * 64, hi);
    unsigned sel = 0u;
    if (n > 0) {
        f32x16 g;
#pragma unroll
        for (int r = 0; r < 16; ++r) g[r] = 0.f;
        const bf16* kmr = KM + (((size_t)b * 8 + h) * 8 + (r32 & 7)) * 64;
#pragma unroll
        for (int d0 = 0; d0 < 4; ++d0) { bf16x8 a = *(const bf16x8*)(kmr + d0 * 16 + hi * 8); if (r32 >= 8) a = (bf16x8){0, 0, 0, 0, 0, 0, 0, 0}; g = mfma32(a, qr[d0], g); }
        float gt[8];
#pragma unroll
        for (int i = 0; i < 4; ++i) { const float own = g[i], oth = __shfl_xor(own, 32); gt[i] = hi ? oth : own; gt[4 + i] = hi ? own : oth; }
#pragma unroll
        for (int round = 0; round < 3; ++round) if (round < n) { float best = -INFINITY; int bi = -1;
#pragma unroll
            for (int j = 0; j < 8; ++j) if (j < n && !((sel >> j) & 1u) && gt[j] > best) { best = gt[j]; bi = j; }
            if (bi >= 0) sel |= 1u << bi; }
    }
    AState st; astate_init(st);
    const int nt = 4 * n + 4;
    attn_run(st, lds, qr, nt, P.tid, lane, P.wave,
        [&](int t, int key, const bf16*& kp, const bf16*& vp) { const bf16* rp = PROJ + (rowbase + 64 * t + key) * EV_NP + h * 64; kp = rp + C_KB; vp = rp + C_VB; },
        [&](int t) { const int blk = t >> 2; if (blk < n) return __any((sel >> blk) & 1u) != 0; return 64 * (t - 4 * n) <= 32 * P.wave + 31; },
        [&](int t, f32x16& p0, f32x16& p1) { const int blk = t >> 2;
            if (blk < n) { if (!((sel >> blk) & 1u)) {
#pragma unroll
                    for (int r = 0; r < 16; ++r) { p0[r] = -INFINITY; p1[r] = -INFINITY; } } }
            else { const int kb = 64 * (t - 4 * n) + 4 * hi, qrel = 32 * P.wave + r32;
#pragma unroll
                for (int r = 0; r < 16; ++r) { if (kb + CR(r) > qrel) p0[r] = -INFINITY; if (kb + 32 + CR(r) > qrel) p1[r] = -INFINITY; } } });
    LAS float* wsf = (LAS float*)(lds + AT_WSF) + P.wave * 64;
    (void)attn_finish(st, wsf, lane, [&](int rr) { return O + (rowbase + q0 + rr) * DM + 512 + h * 64; });
}
DI void phase_attn_even(const Ptrs& P, LAS unsigned char* lds) {
    for (int k = 0; ; ++k) { const int u = P.bid + P.G * k; if (u >= 512) break;
        const int b = u & 7, v = u >> 3, a = v & 31; dsa_unit(P, lds, b, (v >> 5) ? 63 - a : a); }
    for (int k = 0; ; ++k) { const int u = P.bid + P.G * k; if (u >= 512) break;
        const int b = u & 7, h = (u >> 3) & 7, v = u >> 6; moba_unit(P, lds, b, h, v < 4 ? v : 11 - v); }
}
constexpr int B3_K = 128 * KROW, B3_V = 2 * 128 * 64, B3_HALF = B3_K + B3_V, B3_WSF = 2 * B3_HALF;
DI void b3_unit(const Ptrs& P, LAS unsigned char* lds, int b, int h, int rp) {
    const bf16* PROJ = (const bf16*)(P.ws + WS_R1); bf16* O = (bf16*)(P.ws + WS_O); float* LSE3 = (float*)(P.ws + WS_MISC + MS_LSE3);
    const int lane = P.lane, r32 = lane & 31, hi = lane >> 5, half = P.wave >> 2, wi = P.wave & 3, r16 = 2 * rp + half; const size_t rowbase = (size_t)b * SEQ;
    LAS unsigned char* kh = lds + half * B3_HALF; LAS unsigned char* vh = kh + B3_K;
    const int th = P.tid & 255;
#pragma unroll
    for (int k = 0; k < 4; ++k) { const int idx = th + 256 * k, key = idx >> 3, chunk = idx & 7; const bf16* rpn = PROJ + (rowbase + 16 * key + r16) * OD_N + h * 64;
        TileRegs tr; tile_load(tr, rpn + OC_K, rpn + OC_V, chunk); tile_store(kh, vh, 128 * 64, tr, key, chunk); }
    bf16x8 qr[4]; load_q(qr, PROJ + (rowbase + 16 * (32 * wi + r32) + r16) * OD_N + OC_Q + h * 64, hi);
    __syncthreads();
    AState st; astate_init(st);
    LAS float* wsf = (LAS float*)(lds + B3_WSF) + P.wave * 64;
    for (int T = 0; T <= (wi >> 1); ++T)
        attn_tile(st, kh + 64 * T * KROW, vh + 64 * T * 64, 128 * 64, qr, wsf, lane, [&](f32x16& p0, f32x16& p1) { const int kb = 64 * T + 4 * hi, wq = 32 * wi + r32;
#pragma unroll
            for (int r = 0; r < 16; ++r) { if (kb + CR(r) > wq) p0[r] = -INFINITY; if (kb + 32 + CR(r) > wq) p1[r] = -INFINITY; } });
    const float lt = attn_finish(st, wsf, lane, [&](int rr) { return O + (rowbase + 16 * (32 * wi + rr) + r16) * DM + h * 64; });
    if (hi == 0) LSE3[(rowbase + 16 * (32 * wi + r32) + r16) * 16 + h] = st.m + __builtin_amdgcn_logf(lt);
    __syncthreads();
}
DI void phase_b3(const Ptrs& P, LAS unsigned char* lds) {
    for (int k = 0; ; ++k) { const int u = P.bid + P.G * k; if (u >= 1024) break; b3_unit(P, lds, u & 7, (u >> 3) & 15, u >> 7); }
}
DI void band_unit(const Ptrs& P, LAS unsigned char* lds, int b, int h, int qb) {
    const bf16* PROJ = (const bf16*)(P.ws + WS_R1); bf16* O = (bf16*)(P.ws + WS_O); const float* LSE3 = (const float*)(P.ws + WS_MISC + MS_LSE3);
    const int lane = P.lane, r32 = lane & 31, hi = lane >> 5; const size_t rowbase = (size_t)b * SEQ; const int t0w = 256 * qb + 32 * P.wave;
    bf16x8 qr[4]; load_q(qr, PROJ + (rowbase + t0w + r32) * OD_N + OC_Q + h * 64, hi);
    AState st; st.m = LSE3[(rowbase + t0w + r32) * 16 + h]; st.l = hi ? 0.f : 1.f;
#pragma unroll
    for (int r = 0; r < 16; ++r) { const bf16* orow = O + (rowbase + t0w + CR(r) + 4 * hi) * DM + h * 64 + r32; st.o0[r] = bf2f(orow[0]); st.o1[r] = bf2f(orow[32]); }
    const int kt_lo = (4 * qb - 8 > 0) ? 4 * qb - 8 : 0, nt = 4 * qb + 4 - kt_lo;
    attn_run(st, lds, qr, nt, P.tid, lane, P.wave,
        [&](int t, int key, const bf16*& kp, const bf16*& vp) { const bf16* rp = PROJ + (rowbase + 64 * (kt_lo + t) + key) * OD_N + h * 64; kp = rp + OC_K; vp = rp + OC_V; },
        [&](int t) { const int k0 = 64 * (kt_lo + t); return (k0 + 63 >= t0w - 512) && (k0 <= t0w + 31); },
        [&](int t, f32x16& p0, f32x16& p1) { const int dq = (t0w + r32) - (64 * (kt_lo + t) + 4 * hi);
#pragma unroll
            for (int r = 0; r < 16; ++r) {
                { const int d = dq - CR(r); const int mult = ((unsigned)d <= 128u ? 1 : 0) + (((unsigned)d <= 512u && (d & 3) == 0) ? 1 : 0); p0[r] = mult == 0 ? -INFINITY : (mult == 2 ? p0[r] + 1.0f : p0[r]); }
                { const int d = dq - 32 - CR(r); const int mult = ((unsigned)d <= 128u ? 1 : 0) + (((unsigned)d <= 512u && (d & 3) == 0) ? 1 : 0); p1[r] = mult == 0 ? -INFINITY : (mult == 2 ? p1[r] + 1.0f : p1[r]); } } });
    LAS float* wsf = (LAS float*)(lds + AT_WSF) + P.wave * 64;
    (void)attn_finish(st, wsf, lane, [&](int rr) { return O + (rowbase + t0w + rr) * DM + h * 64; });
}
DI void phase_band(const Ptrs& P, LAS unsigned char* lds) {
    for (int k = 0; ; ++k) { const int u = P.bid + P.G * k; if (u >= 1024) break; band_unit(P, lds, u & 7, (u >> 3) & 15, u >> 7); }
}

struct Args { const float* in[20]; float* out; unsigned char* ws; int ph_lo, ph_hi; };
constexpr int NPH_PAIR = 21, NPH = 2 * NPH_PAIR;
constexpr int PT_OFF = LDS_BYTES - 512;
DI unsigned long long uni64(unsigned long long v) { const unsigned lo = __builtin_amdgcn_readfirstlane((unsigned)v), hi = __builtin_amdgcn_readfirstlane((unsigned)(v >> 32)); return ((unsigned long long)hi << 32) | lo; }
DI Ptrs load_ptrs(LAS unsigned char* lds) {
    Ptrs P; const LAS unsigned long long* t = (const LAS unsigned long long*)(lds + PT_OFF);
#pragma unroll
    for (int i = 0; i < 20; ++i) P.in[i] = (const float*)uni64(t[i]);
    P.out = (float*)uni64(t[20]); P.ws = (unsigned char*)uni64(t[21]);
    int tid_ = threadIdx.x; asm volatile("" : "+v"(tid_)); P.tid = tid_; P.lane = P.tid & 63; P.wave = __builtin_amdgcn_readfirstlane(P.tid >> 6); P.bid = blockIdx.x; P.G = gridDim.x;
    return P;
}
DI void grid_bar(LAS unsigned char* lds) {
    const Ptrs P = load_ptrs(lds);
    XcdBarrier bar; bar.bar = (unsigned*)(P.ws + WS_CTL) + CW_BAR; bar.x = xb_xcc_id(); bar.st = (volatile LAS unsigned*)(lds + LDS_BYTES - 16);
    xcd_barrier(bar);
}
__global__ void __launch_bounds__(NTHR, 2) fwd(Args args) {
    extern __shared__ __attribute__((aligned(16))) unsigned char lds_raw[];
    LAS unsigned char* lds = (LAS unsigned char*)lds_raw;
    const int lo = args.ph_lo, hi = args.ph_hi;
    {   LAS unsigned long long* t = (LAS unsigned long long*)(lds + PT_OFF);
        if (threadIdx.x == 0) {
#pragma unroll
            for (int i = 0; i < 20; ++i) t[i] = (unsigned long long)args.in[i];
            t[20] = (unsigned long long)args.out; t[21] = (unsigned long long)args.ws; }
        volatile LAS unsigned* bst = (volatile LAS unsigned*)(lds + LDS_BYTES - 16);
        if (threadIdx.x == 0) { bst[0] = 0u; bst[1] = 0u; }
        __syncthreads();
        if (hi - lo > 1) (void)xcd_barrier_post((unsigned*)(args.ws + WS_CTL) + CW_BAR, bst);
    }
#define PTRS() const Ptrs P = load_ptrs(lds); bf16* WIN = (bf16*)(P.ws + WS_WIN); bf16* WOUT = (bf16*)(P.ws + WS_WOUT); bf16* WUP = (bf16*)(P.ws + WS_WUP); bf16* WDN = (bf16*)(P.ws + WS_WDN); \
    float* XF = (float*)(P.ws + WS_XF); bf16* XB = (bf16*)(P.ws + WS_XB); bf16* PROJ = (bf16*)(P.ws + WS_R1); bf16* OB = (bf16*)(P.ws + WS_O); bf16* HB = (bf16*)(P.ws + WS_R1); \
    float* MIX = (float*)(P.ws + WS_MIX); bf16* XBUF = (bf16*)(P.ws + WS_XBUF); const int* pblk = (const int*)(P.ws + WS_MISC + MS_PBLK); \
    (void)WIN; (void)WOUT; (void)WUP; (void)WDN; (void)XF; (void)XB; (void)PROJ; (void)OB; (void)HB; (void)MIX; (void)XBUF; (void)pblk;

    for (int pair = 0; pair < 2; ++pair) {
        const int base = pair * NPH_PAIR;
#ifndef PHMASK
#define PHMASK 0x1fffff
#endif
#define IN(k) (((PHMASK >> (k)) & 1) && lo <= base + (k) && base + (k) < hi)
#define SEAM(k) do { if (base + (k) + 1 < hi) grid_bar(lds); } while (0)
        if (IN(0)) { PTRS(); if (pair == 0) phase_init(P); phase_convert_even(P, lds, pair); SEAM(0); }
        if (IN(1)) { PTRS(); pg8::Gemm g{XB, WIN, NTOK, EV_NP, DM}; pg8::StaticOrder S; S.init(NTOK, EV_NP, P.G, P.bid); pg8::EpiStoreBf16 E{PROJ, EV_NP};
            pg8::gemm_phase<pg8::EpiStoreBf16, pg8::StaticOrder, true, true>(lds, g, S, E); SEAM(1); }
        if (IN(2)) { PTRS(); phase_rope_even(P); SEAM(2); }
        if (IN(3)) { PTRS(); phase_index(P, lds); SEAM(3); }
        if (IN(4)) { PTRS(); phase_attn_even(P, lds); SEAM(4); }
        if (IN(5)) { PTRS(); pg8::Gemm g{OB, WOUT, NTOK, DM, DM}; pg8::StaticOrder S; S.init(NTOK, DM, P.G, P.bid); pg8::EpiF32 E{MIX, DM, pair == 0 ? P.in[0] : (const float*)XF, ALPHA};
            pg8::gemm_phase<pg8::EpiF32, pg8::StaticOrder, true, true>(lds, g, S, E); SEAM(5); }
        if (IN(6)) { PTRS(); phase_ln<false>(P, lds, P.in[3] + pair * DM, P.in[4] + pair * DM, XF, XB, nullptr); SEAM(6); }
        if (IN(7)) { PTRS(); pg8::Gemm g{XB, WUP, NTOK, 2 * FF, DM}; pg8::StaticOrder S; S.init(NTOK, 2 * FF, P.G, P.bid); pg8::EpiSwiGLU E{HB, FF};
            pg8::gemm_phase<pg8::EpiSwiGLU, pg8::StaticOrder, true, true>(lds, g, S, E); SEAM(7); }
        if (IN(8)) { PTRS(); pg8::Gemm g{HB, WDN, NTOK, DM, FF}; pg8::StaticOrder S; S.init(NTOK, DM, P.G, P.bid); pg8::EpiF32 E{MIX, DM, XF, ALPHA};
            pg8::gemm_phase<pg8::EpiF32, pg8::StaticOrder, true, true>(lds, g, S, E); SEAM(8); }
        if (IN(9)) { PTRS(); phase_ln<false>(P, lds, P.in[8] + pair * DM, P.in[9] + pair * DM, XF, XB, nullptr); SEAM(9); }
        if (IN(10)) { PTRS(); phase_convert_odd(P, lds, pair); SEAM(10); }
        if (IN(11)) { PTRS(); pg8::Gemm g{XB, WIN, NTOK, OD_N, DM}; pg8::StaticOrder S; S.init(NTOK, OD_N, P.G, P.bid); pg8::EpiStoreBf16 E{PROJ, OD_N};
            pg8::gemm_phase<pg8::EpiStoreBf16, pg8::StaticOrder, true, true>(lds, g, S, E); SEAM(11); }
        if (IN(12)) { PTRS(); phase_rope_odd(P); SEAM(12); }
        if (IN(13)) { PTRS(); phase_b3(P, lds); SEAM(13); }
        if (IN(14)) { PTRS(); phase_band(P, lds); SEAM(14); }
        if (IN(15)) { PTRS(); pg8::Gemm g{OB, WOUT, NTOK, DM, DM}; pg8::StaticOrder S; S.init(NTOK, DM, P.G, P.bid); pg8::EpiF32 E{MIX, DM, XF, ALPHA};
            pg8::gemm_phase<pg8::EpiF32, pg8::StaticOrder, true, true>(lds, g, S, E); SEAM(15); }
        if (IN(16)) { PTRS(); phase_ln<true>(P, lds, P.in[12] + pair * DM, P.in[13] + pair * DM, XF, XB, P.in[14] + (size_t)pair * DM * NEXP); SEAM(16); }
        if (IN(17)) { PTRS(); phase_route(P, lds); SEAM(17); }
        if (IN(18)) { PTRS(); pg8::Gemm g{XBUF, WUP, MOE_ROWS, 2 * FFE, DM}; pg8::MoeOrder S; S.init(pblk, 2 * FFE / 256, (long)2 * FFE * DM * 2, P.G, P.bid); pg8::EpiSwiGLU E{HB, FFE};
            pg8::gemm_phase<pg8::EpiSwiGLU, pg8::MoeOrder, true, true>(lds, g, S, E); SEAM(18); }
        if (IN(19)) { PTRS(); pg8::Gemm g{HB, WDN, MOE_ROWS, DM, FFE}; pg8::MoeOrder S; S.init(pblk, DM / 256, (long)DM * FFE * 2, P.G, P.bid); pg8::EpiF32 E{MIX, DM, nullptr, 0.f};
            pg8::gemm_phase<pg8::EpiF32, pg8::MoeOrder, true, true>(lds, g, S, E); SEAM(19); }
        if (IN(20)) { PTRS(); phase_moe_combine(P, P.in[18] + pair * DM, P.in[19] + pair * DM, pair == 1 ? P.out : XF, pair == 1 ? nullptr : XB); SEAM(20); }
#undef IN
#undef SEAM
    }
}

#ifdef DBG_STOP
__global__ void dbg_dump(float* out, const unsigned char* ws, const float* x, int src) {
    const size_t n = (size_t)NTOK * DM;
    for (size_t i = (size_t)blockIdx.x * blockDim.x + threadIdx.x; i < n; i += (size_t)gridDim.x * blockDim.x) {
        float v;
        switch (src) {
            case 0: v = x[i]; break;
            case 1: v = bf2f(((const bf16*)(ws + WS_XB))[i]); break;
            case 2: v = bf2f(((const bf16*)(ws + WS_R1))[i]); break;
            case 3: v = ((const float*)(ws + WS_MIX))[i]; break;
            case 4: v = ((const float*)(ws + WS_XF))[i]; break;
            case 5: v = bf2f(((const bf16*)(ws + WS_O))[i]); break;
            case 8: { const float o = bf2f(((const bf16*)(ws + WS_O))[i]); const bool bad = !(fabsf(o) < 1e30f); v = ((i & 1023) < 512) ? (bad ? 1000.f : 0.f) : 0.f; } break;
            case 10: { const float o = bf2f(((const bf16*)(ws + WS_O))[i]); const bool bad = !(fabsf(o) < 1e30f); const int t = (int)((i >> 10) & 2047); v = ((i & 1023) < 512 && bad) ? 32.f * (float)(1 << (t >> 8)) : 0.f; } break;
            case 11: { const float o = bf2f(((const bf16*)(ws + WS_O))[i]); const bool bad = !(fabsf(o) < 1e30f); const int b = (int)(i >> 21); v = ((i & 1023) < 512 && bad) ? 32.f * (float)(1 << b) : 0.f; } break;
            case 12: { const float o = bf2f(((const bf16*)(ws + WS_O))[i]); const bool bad = !(fabsf(o) < 1e30f); const int t = (int)((i >> 10) & 2047); v = ((i & 1023) < 512 && bad) ? 32.f * (float)(1 << ((t >> 5) & 7)) : 0.f; } break;
            case 13: { const float o = bf2f(((const bf16*)(ws + WS_O))[i]); const bool bad = !(fabsf(o) < 1e30f); const int hh = (int)((i >> 6) & 7); v = ((i & 1023) < 512 && bad) ? 32.f * (float)(1 << hh) : 0.f; } break;
            case 14: { v = 0.f; if ((i & 1023) == 0) { const int row = (int)(i >> 10); int cnt = 0; for (int w = 0; w < 64; ++w) cnt += __popc(((const unsigned*)(ws + WS_MASK))[row * 64 + w]); const int t = row & 2047; const int ex = t + 1 < 256 ? t + 1 : 256; v = (cnt != ex) ? 1000.f : 0.f; } } break;
            case 15: { const float o = bf2f(((const bf16*)(ws + WS_O))[i]); v = ((i & 1023) < 512) ? o : 0.f; } break;
            case 9: { const float o = bf2f(((const bf16*)(ws + WS_O))[i]); const bool bad = !(fabsf(o) < 1e30f); v = ((i & 1023) >= 512) ? (bad ? 1000.f : 0.f) : 0.f; } break;
            case 6: v = (float)(((const unsigned*)(ws + WS_MASK))[i & (NTOK * 64 - 1)] & 0xffffu); break;
            case 7: v = bf2f(((const bf16*)(ws + WS_WUP))[i]); break;
            default: v = 0.f;
        }
        out[i] = v;
    }
}
#endif
#ifndef MK_SPLIT
#define MK_SPLIT 1
#endif
extern "C" void kernel_launch(void* const* d_in, const int* in_sizes, int n_in, void* d_out, int out_size, void* d_ws, size_t ws_size, hipStream_t stream) {
    static int grid = 0;
    if (grid == 0) {
        if (n_in != 20 || in_sizes[0] != NTOK * DM || out_size != NTOK * DM || ws_size < WS_END) { fprintf(stderr, "kernel_launch: unexpected problem (n_in %d, in0 %d, out %d, ws %zu); nothing launched\n", n_in, n_in > 0 ? in_sizes[0] : -1, out_size, ws_size); grid = -1; return; }
        int dev = 0, cus = 0, per_cu = 0;
        if (hipGetDevice(&dev) != hipSuccess || hipDeviceGetAttribute(&cus, hipDeviceAttributeMultiprocessorCount, dev) != hipSuccess) { grid = -1; return; }
        if (hipFuncSetAttribute((const void*)fwd, hipFuncAttributeMaxDynamicSharedMemorySize, LDS_BYTES) != hipSuccess) { fprintf(stderr, "kernel_launch: hipFuncSetAttribute failed\n"); grid = -1; return; }
        if (hipOccupancyMaxActiveBlocksPerMultiprocessor(&per_cu, (const void*)fwd, NTHR, LDS_BYTES) != hipSuccess || per_cu < 1) fprintf(stderr, "kernel_launch: note: occupancy query reports %d\n", per_cu);
        (void)hipGetLastError();
        grid = cus;
    }
    if (grid < 0) return;
    if (hipMemsetAsync((char*)d_ws + WS_CTL, 0, CTL_ZERO_BYTES, stream) != hipSuccess) return;
    Args a{};
    for (int i = 0; i < 20; ++i) a.in[i] = (const float*)d_in[i];
    a.out = (float*)d_out; a.ws = (unsigned char*)d_ws;
#ifdef DBG_STOP
    for (int p = 0; p < DBG_STOP; ++p) { a.ph_lo = p; a.ph_hi = p + 1; hipLaunchKernelGGL(fwd, dim3(grid), dim3(NTHR), LDS_BYTES, stream, a); }
    hipLaunchKernelGGL(dbg_dump, dim3(1024), dim3(256), 0, stream, (float*)d_out, (const unsigned char*)d_ws, (const float*)d_in[0], (int)DBG_SRC);
#elif MK_SPLIT
#ifndef REP_MASK
#define REP_MASK 0
#endif
    for (int p = 0; p < NPH; ++p) { a.ph_lo = p; a.ph_hi = p + 1; const int reps = ((REP_MASK >> (p % NPH_PAIR)) & 1) ? 2 : 1;
        for (int r = 0; r < reps; ++r) hipLaunchKernelGGL(fwd, dim3(grid), dim3(NTHR), LDS_BYTES, stream, a); }
#else
    a.ph_lo = 0; a.ph_hi = NPH; hipLaunchKernelGGL(fwd, dim3(grid), dim3(NTHR), LDS_BYTES, stream, a);
#endif
}
```

```cpp
#include <hip/hip_runtime.h>
#include <cstdio>
#include <cstdint>
#define MK_SPLIT 0
namespace pg8 {
#define PG8_LAS __attribute__((address_space(3)))
typedef unsigned short bf16_t;
typedef short bf16x8 __attribute__((ext_vector_type(8)));
typedef float f32x4 __attribute__((ext_vector_type(4)));
typedef unsigned u32x4 __attribute__((ext_vector_type(4)));
constexpr int BM = 256, BK = 64, HALF = 128, HTB = HALF * BK * 2  , STAGE_BYTES = 8 * HTB, NXCD = 8, WGM = 8;

__host__ __device__ __forceinline__ int lds_byte(int r, int c) { const int st = (r >> 4) * 2 + (c >> 5), rr = r & 15, cc = c & 31, ob = rr * 64 + cc * 2; return st * 1024 + (ob ^ (((ob >> 9) & 1) << 5)); }
__host__ __device__ __forceinline__ void stage_rc(int b, int& R, int& C) { const int st = b / 1024, sb = b % 1024, swz = sb ^ (((sb >> 9) & 1) << 5); R = (st >> 1) * 16 + swz / 64; C = (st & 1) * 32 + (swz % 64) / 2; }
__host__ __device__ __forceinline__ int perm32(int rho) { const int n = rho >> 4, i = rho & 15; return 8 * (i >> 2) + 4 * n + (i & 3); }

struct Unit { int pm, pn; long boff; };
struct Gemm { const bf16_t* A; const bf16_t* Bt; int M, N, K; };

struct StaticOrder {
    int nM, nN, nwg, G, c;
    __host__ __device__ void init(int M, int N, int G_, int c_) { nM = M / BM; nN = N / BM; nwg = nM * nN; G = G_; c = c_; }
    __host__ __device__ bool next(int i, Unit& u) const {
        const long L = (long)i * G + c; if (L >= nwg) return false;
        int wgid = (int)L; { const int q = nwg / NXCD, r = nwg % NXCD, xcd = wgid % NXCD, off = wgid / NXCD; wgid = (xcd < r ? xcd * (q + 1) : r * (q + 1) + (xcd - r) * q) + off; }
        const int nig = WGM * nN, gid = wgid / nig, fm = gid * WGM, gsz = (nM - fm) < WGM ? (nM - fm) : WGM;
        u.pm = fm + ((wgid % nig) % gsz); u.pn = (wgid % nig) / gsz; u.boff = 0; return true;
    }
    __device__ __forceinline__ void a_ready(const Unit&) const {}
    __device__ __forceinline__ void done(const Unit&) const {}
};

__device__ __forceinline__ unsigned cvt_pk_bf16(float lo, float hi) { unsigned r; asm volatile("v_cvt_pk_bf16_f32 %0, %1, %2" : "=v"(r) : "v"(lo), "v"(hi)); return r; }
struct EpiStoreBf16 {
    static constexpr bool PERM = true, AFTER_DRAIN = false;
    bf16_t* O; int ldc;
    __device__ __forceinline__ void operator()(const f32x4 (&acc)[2][2][4][2], const Unit& u, int wr, int wc, int fr, int fq) const {
        const int row0 = u.pm * BM + wr * 64 + fr, col0 = u.pn * BM + wc * 32 + 8 * fq;
#pragma unroll
        for (int ai = 0; ai < 2; ++ai)
#pragma unroll
            for (int m = 0; m < 4; ++m) { bf16_t* rowp = O + (size_t)(row0 + ai * HALF + m * 16) * ldc + col0;
#pragma unroll
                for (int bj = 0; bj < 2; ++bj) { const f32x4 v0 = acc[ai][bj][m][0], v1 = acc[ai][bj][m][1];
                    u32x4 w; w.x = cvt_pk_bf16(v0[0], v0[1]); w.y = cvt_pk_bf16(v0[2], v0[3]); w.z = cvt_pk_bf16(v1[0], v1[1]); w.w = cvt_pk_bf16(v1[2], v1[3]);
                    *(u32x4*)(rowp + bj * HALF) = w; } }
    }
};
__device__ __forceinline__ float silu_mul(float g, float u) { return g * u * __builtin_amdgcn_rcpf(1.0f + __builtin_amdgcn_exp2f(-1.4426950408889634f * g)); }
struct EpiSwiGLU {
    static constexpr bool PERM = true, AFTER_DRAIN = false;
    bf16_t* H; int ldh;
    __device__ __forceinline__ void operator()(const f32x4 (&acc)[2][2][4][2], const Unit& u, int wr, int wc, int fr, int fq) const {
        const int row0 = u.pm * BM + wr * 64 + fr, col0 = u.pn * HALF + wc * 32 + 8 * fq;
#pragma unroll
        for (int ai = 0; ai < 2; ++ai)
#pragma unroll
            for (int m = 0; m < 4; ++m) { bf16_t* rowp = H + (size_t)(row0 + ai * HALF + m * 16) * ldh + col0;
                const f32x4 g0 = acc[ai][0][m][0], g1 = acc[ai][0][m][1], u0 = acc[ai][1][m][0], u1 = acc[ai][1][m][1];
                u32x4 w; w.x = cvt_pk_bf16(silu_mul(g0[0], u0[0]), silu_mul(g0[1], u0[1])); w.y = cvt_pk_bf16(silu_mul(g0[2], u0[2]), silu_mul(g0[3], u0[3]));
                w.z = cvt_pk_bf16(silu_mul(g1[0], u1[0]), silu_mul(g1[1], u1[1])); w.w = cvt_pk_bf16(silu_mul(g1[2], u1[2]), silu_mul(g1[3], u1[3]));
                *(u32x4*)rowp = w; }
    }
};
struct EpiF32 {
    static constexpr bool PERM = false, AFTER_DRAIN = false;
    float* O; int ldc; const float* R; float alpha;
    __device__ __forceinline__ void operator()(const f32x4 (&acc)[2][2][4][2], const Unit& u, int wr, int wc, int fr, int fq) const {
        const int row0 = u.pm * BM + wr * 64 + fr, col0 = u.pn * BM + wc * 32 + 4 * fq;
#pragma unroll
        for (int ai = 0; ai < 2; ++ai)
#pragma unroll
            for (int m = 0; m < 4; ++m) { const size_t off = (size_t)(row0 + ai * HALF + m * 16) * ldc + col0;
#pragma unroll
                for (int bj = 0; bj < 2; ++bj)
#pragma unroll
                    for (int n = 0; n < 2; ++n) { f32x4 v = acc[ai][bj][m][n]; if (R) v += alpha * *(const f32x4*)(R + off + bj * HALF + n * 16); *(f32x4*)(O + off + bj * HALF + n * 16) = v; } }
    }
};
struct MoeOrder {
    int nN, nunits, G, c; long estride; int pb[9];
    __device__ __forceinline__ void init(const int* pblk, int nN_, long estride_, int G_, int c_) { nN = nN_; G = G_; c = c_; estride = estride_;
#pragma unroll
        for (int e = 0; e < 9; ++e) pb[e] = __builtin_amdgcn_readfirstlane(pblk[e]);
        nunits = pb[8] * nN; }
    __device__ __forceinline__ bool next(int i, Unit& u) const {
        const int L = i * G + c; if (L >= nunits) return false;
        u.pm = L / nN; u.pn = L - u.pm * nN; int e = 0;
#pragma unroll
        for (int k = 1; k < 8; ++k) e += (u.pm >= pb[k]) ? 1 : 0;
        u.boff = (long)e * estride; return true; }
    __device__ __forceinline__ void a_ready(const Unit&) const {}
    __device__ __forceinline__ void done(const Unit&) const {}
};
template <class Epi, class Sched, bool ALIGN_EPI = false, bool SP2 = false>
__device__ __forceinline__ void gemm_phase(PG8_LAS unsigned char* lds, const Gemm g, const Sched& S, const Epi& E) {
    int tid_ = threadIdx.x; asm volatile("" : "+v"(tid_));
    const int tid = tid_, wid = __builtin_amdgcn_readfirstlane(tid >> 6), lane = tid & 63, wr = wid >> 2, wc = wid & 3, fr = lane & 15, fq = lane >> 4;
    const int K = g.K, nt = K / BK;
    unsigned voffA[2], voffB[2];
#pragma unroll
    for (int i = 0; i < 2; ++i) { int R, C; stage_rc(tid * 16 + i * 8192, R, C); const int Rb = Epi::PERM ? ((R & ~31) + perm32(R & 31)) : R;
        voffA[i] = (unsigned)(R * K + C) * 2u; voffB[i] = (unsigned)(Rb * K + C) * 2u; }
    const size_t kstep = (size_t)(BK * 2);
    const size_t hstep = (size_t)HALF * K * 2;
    const size_t tstep = 2 * hstep;
    const unsigned ldsw = (unsigned)wid * 1024u;
    const int aoff = lds_byte(wr * 64 + fr, fq * 8), boff = lds_byte(wc * 32 + fr, fq * 8);
#define PG8_SA(b, h) (((b) * 2 + (h)) * HTB)
#define PG8_SB(b, h) ((4 + (b) * 2 + (h)) * HTB)
#define PG8_STAGE(bufoff, gbase, voff) do { _Pragma("unroll") for (int _i = 0; _i < 2; ++_i) \
        __builtin_amdgcn_global_load_lds((const unsigned*)((const char*)(gbase) + (voff)[_i]), (PG8_LAS unsigned*)(lds + (bufoff) + ldsw + _i * 8192), 16, 0, 0); } while (0)
#define PG8_LDA(dst, b, h) do { _Pragma("unroll") for (int m = 0; m < 4; ++m) _Pragma("unroll") for (int k = 0; k < 2; ++k) dst[m][k] = *(const PG8_LAS bf16x8*)(lds + PG8_SA(b, h) + aoff + m * 2048 + k * 1024); } while (0)
#define PG8_LDB(dst, b, h) do { _Pragma("unroll") for (int n = 0; n < 2; ++n) _Pragma("unroll") for (int k = 0; k < 2; ++k) dst[n][k] = *(const PG8_LAS bf16x8*)(lds + PG8_SB(b, h) + boff + n * 2048 + k * 1024); } while (0)
#define PG8_MMA(ai, bj, At, Bt) do { __builtin_amdgcn_s_setprio(1); _Pragma("unroll") for (int m = 0; m < 4; ++m) _Pragma("unroll") for (int n = 0; n < 2; ++n) _Pragma("unroll") for (int k = 0; k < 2; ++k) \
        acc[ai][bj][m][n] = __builtin_amdgcn_mfma_f32_16x16x32_bf16(Bt[n][k], At[m][k], acc[ai][bj][m][n], 0, 0, 0); __builtin_amdgcn_s_setprio(0); } while (0)
#define PG8_WAIT_V(n) asm volatile("s_waitcnt vmcnt(" #n ")" ::: "memory")
#define PG8_WAIT_L(n) asm volatile("s_waitcnt lgkmcnt(" #n ")" ::: "memory")
#define PG8_BAR __builtin_amdgcn_s_barrier()
#define PG8_SCHED __builtin_amdgcn_sched_barrier(0)
    Unit cur, nxt; int ui = 0;
    if (!S.next(0, cur)) return;
    f32x4 acc[2][2][4][2];
#pragma unroll
    for (int a = 0; a < 2; ++a)
#pragma unroll
        for (int b = 0; b < 2; ++b)
#pragma unroll
            for (int m = 0; m < 4; ++m)
#pragma unroll
                for (int n = 0; n < 2; ++n) acc[a][b][m][n] = (f32x4){0.f, 0.f, 0.f, 0.f};
    bf16x8 At[4][2], B0[2][2], B1[2][2];
    const char* cA = (const char*)g.A + (size_t)cur.pm * tstep; const char* cB = (const char*)g.Bt + cur.boff + (size_t)cur.pn * tstep;
    S.a_ready(cur);
    if constexpr (SP2) {
        PG8_STAGE(PG8_SB(0, 0), cB, voffB); PG8_STAGE(PG8_SB(0, 1), cB + hstep, voffB); PG8_STAGE(PG8_SA(0, 0), cA, voffA); PG8_STAGE(PG8_SA(0, 1), cA + hstep, voffA);
        if (wr == 1) PG8_BAR;
        PG8_WAIT_V(2); PG8_BAR;
        PG8_STAGE(PG8_SB(1, 0), cB + kstep, voffB); PG8_STAGE(PG8_SA(1, 0), cA + kstep, voffA); PG8_STAGE(PG8_SB(1, 1), cB + hstep + kstep, voffB);
        PG8_WAIT_V(6); PG8_BAR;
    } else {
        PG8_STAGE(PG8_SB(0, 0), cB, voffB); PG8_STAGE(PG8_SA(0, 0), cA, voffA); PG8_STAGE(PG8_SB(0, 1), cB + hstep, voffB); PG8_STAGE(PG8_SA(0, 1), cA + hstep, voffA);
        if (wr == 1) PG8_BAR;
        PG8_WAIT_V(4); PG8_BAR;
        PG8_STAGE(PG8_SB(1, 0), cB + kstep, voffB); PG8_STAGE(PG8_SA(1, 0), cA + kstep, voffA); PG8_STAGE(PG8_SB(1, 1), cB + hstep + kstep, voffB);
        PG8_WAIT_V(6); PG8_BAR;
    }
    for (;;) {
        const bool has_next = S.next(ui + 1, nxt);
        const char* nA = has_next ? (const char*)g.A + (size_t)nxt.pm * tstep : cA; const char* nB = has_next ? (const char*)g.Bt + nxt.boff + (size_t)nxt.pn * tstep : cB;
        for (int t = 0; t < nt; t += 2) {
            const bool last = (t == nt - 2);
            const char* a1 = cA + (size_t)(t + 1) * kstep;
            const char* a2 = last ? nA : cA + (size_t)(t + 2) * kstep; const char* b2 = last ? nB : cB + (size_t)(t + 2) * kstep;
            const char* a3 = a2 + kstep; const char* b3 = b2 + kstep;
            if (last && has_next) S.a_ready(nxt);
            if constexpr (SP2) {
            PG8_LDB(B0, 0, 0); PG8_LDB(B1, 0, 1); PG8_SCHED; PG8_LDA(At, 0, 0); PG8_STAGE(PG8_SA(1, 1), a1 + hstep, voffA);
            PG8_WAIT_V(8); PG8_WAIT_L(0); PG8_BAR; PG8_MMA(0, 0, At, B0); PG8_MMA(0, 1, At, B1); PG8_BAR; PG8_SCHED;
            PG8_LDA(At, 0, 1); PG8_STAGE(PG8_SB(0, 0), b2, voffB); PG8_STAGE(PG8_SB(0, 1), b2 + hstep, voffB); PG8_STAGE(PG8_SA(0, 0), a2, voffA);
            PG8_WAIT_V(8); PG8_WAIT_L(0); PG8_BAR; PG8_MMA(1, 0, At, B0); PG8_MMA(1, 1, At, B1); PG8_BAR; PG8_SCHED;
            PG8_LDB(B0, 1, 0); PG8_LDB(B1, 1, 1); PG8_SCHED; PG8_LDA(At, 1, 0); PG8_STAGE(PG8_SA(0, 1), a2 + hstep, voffA);
            PG8_WAIT_V(8); PG8_WAIT_L(0); PG8_BAR; PG8_MMA(0, 0, At, B0); PG8_MMA(0, 1, At, B1); PG8_BAR; PG8_SCHED;
            PG8_LDA(At, 1, 1); PG8_STAGE(PG8_SB(1, 0), b3, voffB); PG8_STAGE(PG8_SB(1, 1), b3 + hstep, voffB); PG8_STAGE(PG8_SA(1, 0), a3, voffA);
            PG8_WAIT_V(8); PG8_WAIT_L(0); PG8_BAR; PG8_MMA(1, 0, At, B0); PG8_MMA(1, 1, At, B1); PG8_BAR; PG8_SCHED;
            } else {
            PG8_LDB(B0, 0, 0); PG8_SCHED; PG8_LDA(At, 0, 0); PG8_STAGE(PG8_SA(1, 1), a1 + hstep, voffA);
            PG8_WAIT_L(8); PG8_BAR; PG8_WAIT_L(0); PG8_MMA(0, 0, At, B0); PG8_BAR; PG8_SCHED;
            PG8_LDB(B1, 0, 1); PG8_STAGE(PG8_SB(0, 0), b2, voffB);
            PG8_BAR; PG8_WAIT_L(0); PG8_MMA(0, 1, At, B1); PG8_BAR;
            PG8_LDA(At, 0, 1); PG8_STAGE(PG8_SA(0, 0), a2, voffA);
            PG8_BAR; PG8_WAIT_L(0); PG8_MMA(1, 0, At, B0); PG8_BAR; PG8_SCHED;
            PG8_STAGE(PG8_SB(0, 1), b2 + hstep, voffB);
            PG8_WAIT_V(6); PG8_BAR; PG8_MMA(1, 1, At, B1); PG8_BAR;
            PG8_LDB(B0, 1, 0); PG8_SCHED; PG8_LDA(At, 1, 0); PG8_STAGE(PG8_SA(0, 1), a2 + hstep, voffA);
            PG8_WAIT_L(8); PG8_BAR; PG8_WAIT_L(0); PG8_MMA(0, 0, At, B0); PG8_BAR; PG8_SCHED;
            PG8_LDB(B1, 1, 1); PG8_STAGE(PG8_SB(1, 0), b3, voffB);
            PG8_BAR; PG8_WAIT_L(0); PG8_MMA(0, 1, At, B1); PG8_BAR;
            PG8_LDA(At, 1, 1); PG8_STAGE(PG8_SA(1, 0), a3, voffA);
            PG8_BAR; PG8_WAIT_L(0); PG8_MMA(1, 0, At, B0); PG8_BAR; PG8_SCHED;
            PG8_STAGE(PG8_SB(1, 1), b3 + hstep, voffB);
            PG8_WAIT_V(6); PG8_BAR; PG8_MMA(1, 1, At, B1); PG8_BAR;
            }
        }
        if constexpr (ALIGN_EPI) { if (wr == 0) PG8_BAR; }
        if constexpr (!Epi::AFTER_DRAIN) { E(acc, cur, wr, wc, fr, fq); S.done(cur); }
        if (!has_next) break;
#pragma unroll
        for (int a = 0; a < 2; ++a)
#pragma unroll
            for (int b = 0; b < 2; ++b)
#pragma unroll
                for (int m = 0; m < 4; ++m)
#pragma unroll
                    for (int n = 0; n < 2; ++n) acc[a][b][m][n] = (f32x4){0.f, 0.f, 0.f, 0.f};
        cur = nxt; cA = nA; cB = nB; ++ui;
        if constexpr (ALIGN_EPI) { if (wr == 1) PG8_BAR; }
    }
    PG8_WAIT_V(0);
    if constexpr (!ALIGN_EPI) { if (wr == 0) PG8_BAR; }
    PG8_BAR;
    if constexpr (Epi::AFTER_DRAIN) { E.fused(acc, cur, wr, wc, fr, fq, lds, wid, lane); S.done(cur); }
#undef PG8_SA
#undef PG8_SB
#undef PG8_STAGE
#undef PG8_LDA
#undef PG8_LDB
#undef PG8_MMA
#undef PG8_WAIT_V
#undef PG8_WAIT_L
#undef PG8_BAR
#undef PG8_SCHED
}
}

#define DI __device__ __forceinline__
#define LAS __attribute__((address_space(3)))
typedef unsigned short bf16;
typedef unsigned u32x4 __attribute__((ext_vector_type(4)));
typedef unsigned u32x2 __attribute__((ext_vector_type(2)));
typedef float f32x4 __attribute__((ext_vector_type(4)));
typedef float f32x2 __attribute__((ext_vector_type(2)));
typedef float f32x16 __attribute__((ext_vector_type(16)));
typedef short bf16x8 __attribute__((ext_vector_type(8)));
typedef short s16x4 __attribute__((ext_vector_type(4)));
typedef unsigned gu32;

constexpr int NB = 8, SEQ = 2048, DM = 1024, NTOK = NB * SEQ;
constexpr int EV_N = 2472, EV_NP = 2560, OD_N = 3072;
constexpr int FF = 2816, FFE = 3584, NEXP = 8;
constexpr int C_QA = 0, C_KA = 512, C_VA = 576, C_IQ = 640, C_IK = 896, C_IW = 928, C_QB = 936, C_KB = 1448, C_VB = 1960;
constexpr int OC_Q = 0, OC_K = 1024, OC_V = 2048;
constexpr float ALPHA = 1.6817928305074290f;
constexpr float LN_EPS = 1e-5f;
constexpr float QSCALE = 0.125f * 1.4426950408889634f;
constexpr int MOE_ROWS = 2 * NTOK + NEXP * 256;
constexpr int NWAVES = 8, NTHR = 512;

constexpr size_t MiB = 1u << 20;
constexpr size_t WS_CTL = 0, CTL_ZERO_BYTES = 1 * MiB;
constexpr size_t WS_TAB = 1 * MiB;
constexpr size_t WS_MISC = 2 * MiB;
constexpr size_t WS_MASK = 6 * MiB;
constexpr size_t WS_WIN = 10 * MiB, WS_WOUT = 18 * MiB, WS_WUP = 20 * MiB, WS_WDN = 132 * MiB;
constexpr size_t WS_XF = 188 * MiB, WS_XB = 252 * MiB;
constexpr size_t WS_R1 = 284 * MiB;
constexpr size_t WS_O = WS_R1 + 96 * MiB;
constexpr size_t WS_MIX = 524 * MiB;
constexpr size_t WS_XBUF = 660 * MiB;
constexpr size_t WS_END = 728 * MiB;
constexpr size_t MS_EID = 0, MS_GATE = 128 * 1024, MS_ROWOF = 256 * 1024, MS_TOKOF = 384 * 1024, MS_KM = 640 * 1024, MS_PBLK = 768 * 1024, MS_LSE3 = 1 * MiB;
constexpr size_t TB_COS64 = 0, TB_SIN64 = 256 * 1024, TB_COS32 = 512 * 1024, TB_SIN32 = 640 * 1024;
constexpr int CW_TMO = 0, CW_BAR = 4096;

constexpr int LDS_BYTES = 152 * 1024;

DI unsigned f2bf(float f) { unsigned u = __builtin_bit_cast(unsigned, f); return (u + 0x7fffu + ((u >> 16) & 1u)) >> 16; }
DI unsigned pk2(float lo, float hi) { return f2bf(lo) | (f2bf(hi) << 16); }
DI float bf2f(unsigned short h) { return __builtin_bit_cast(float, (unsigned)h << 16); }
DI float bflo(unsigned w) { return __builtin_bit_cast(float, w << 16); }
DI float bfhi(unsigned w) { return __builtin_bit_cast(float, w & 0xffff0000u); }
DI float wave_sum(float v) {
#pragma unroll
    for (int o = 1; o < 64; o <<= 1) v += __shfl_xor(v, o);
    return v;
}
#define LDS_WAIT() asm volatile("s_waitcnt lgkmcnt(0)" ::: "memory")
#define XB_TMO      128
#define XB_XCNT(j)  (256  + 64 * (j))
#define XB_XSUB(j)  (1280 + 64 * (j))
#define XB_XGEN(j)  (2304 + 64 * (j))
#define XB_TOP      3328
#define XB_TOPGEN   3392
#define XCD_BAR_WORDS 3456
#define XB_SPIN_CAP (1u << 18)

__device__ __forceinline__ unsigned xb_ld(unsigned* p)              { return __hip_atomic_load(p, __ATOMIC_RELAXED, __HIP_MEMORY_SCOPE_AGENT); }
__device__ __forceinline__ unsigned xb_add(unsigned* p, unsigned v) { return __hip_atomic_fetch_add(p, v, __ATOMIC_RELAXED, __HIP_MEMORY_SCOPE_AGENT); }
__device__ __forceinline__ unsigned xb_xcc_id() { return (unsigned)__builtin_amdgcn_s_getreg((3 << 11) | 20) & 0xFu; }
#define XB_SPIN(cond, bar) do { unsigned _sp = 0; while (cond) { __builtin_amdgcn_s_sleep(1); \
    if ((++_sp & 255u) == 0u) { if (xb_ld(&(bar)[XB_TMO])) break; if (_sp > XB_SPIN_CAP) { atomicAdd(&(bar)[XB_TMO], 1u); break; } } } } while (0)

struct XcdBarrier {
    unsigned* bar; unsigned x;
    volatile LAS unsigned* st;
};

__device__ __forceinline__ XcdBarrier xcd_barrier_post(unsigned* bar, volatile LAS unsigned* st) {
    XcdBarrier b; b.bar = bar; b.x = xb_xcc_id(); b.st = st;
    if (threadIdx.x == 0) (void)xb_add(&bar[XB_XCNT(b.x)], 1u);
    return b;
}
__device__ __forceinline__ void xcd_barrier_complete(unsigned* bar, unsigned x, unsigned& nloc, unsigned& nx) {
    const unsigned G = gridDim.x * gridDim.y * gridDim.z;
    unsigned sum, cnt, mine, sp = 0u;
    for (;;) {
        sum = 0u; cnt = 0u; mine = 0u;
#pragma unroll
        for (unsigned j = 0; j < 16; ++j) { const unsigned c = xb_ld(&bar[XB_XCNT(j)]); sum += c; cnt += (c > 0u) ? 1u : 0u; mine = (j == x) ? c : mine; }
        if (sum == G) break;
        __builtin_amdgcn_s_sleep(1);
        if ((++sp & 255u) == 0u) { if (xb_ld(&bar[XB_TMO])) break; if (sp > XB_SPIN_CAP) { atomicAdd(&bar[XB_TMO], 1u); break; } }
    }
    nloc = mine > 0u ? mine : 1u; nx = cnt > 0u ? cnt : 1u;
}

__device__ __forceinline__ void xcd_barrier(const XcdBarrier& b) {
    asm volatile("s_waitcnt vmcnt(0)" ::: "memory");
    __syncthreads();
    if (threadIdx.x == 0) {
        unsigned* bar = b.bar;
        __builtin_amdgcn_s_waitcnt(0);
        unsigned nloc = b.st[0], nx = b.st[1];
        if (nloc == 0u) { xcd_barrier_complete(bar, b.x, nloc, nx); b.st[0] = nloc; b.st[1] = nx; }
        const unsigned old = xb_add(&bar[XB_XSUB(b.x)], 1u);
        const unsigned gen = old / nloc;
        if (old + 1u == (gen + 1u) * nloc) {
            __builtin_amdgcn_fence(__ATOMIC_RELEASE, "agent");
            asm volatile("s_waitcnt vmcnt(0)" ::: "memory");
            const unsigned og = xb_add(&bar[XB_TOP], 1u);
            const unsigned tg = og / nx;
            if (og + 1u == (tg + 1u) * nx) xb_add(&bar[XB_TOPGEN], 1u);
            else XB_SPIN(xb_ld(&bar[XB_TOPGEN]) == tg, bar);
            __builtin_amdgcn_fence(__ATOMIC_ACQUIRE, "agent");
            xb_add(&bar[XB_XGEN(b.x)], 1u);
            asm volatile("s_waitcnt vmcnt(0)" ::: "memory");
        } else {
            XB_SPIN(xb_ld(&bar[XB_XGEN(b.x)]) == gen, bar);
            __builtin_amdgcn_fence(__ATOMIC_ACQUIRE, "agent");
            asm volatile("s_waitcnt vmcnt(0)" ::: "memory");
        }
    }
    __syncthreads();
}

constexpr int TR_LD = 65;
DI void tr_item(const float* W, int ldw, int nvalid, int k0, int n0, bf16* WT, int K, int drow0, LAS float* scr, int lane) {
    const int nn = n0 + 4 * (lane & 15); const bool ok = nn < nvalid;
    f32x4 v[16];
#pragma unroll
    for (int i = 0; i < 16; ++i) { const int kk = 4 * i + (lane >> 4); v[i] = ok ? *(const f32x4*)(W + (size_t)(k0 + kk) * ldw + nn) : (f32x4){0.f, 0.f, 0.f, 0.f}; }
#pragma unroll
    for (int i = 0; i < 16; ++i) { const int kk = 4 * i + (lane >> 4); LAS float* d = scr + kk * TR_LD + 4 * (lane & 15); d[0] = v[i].x; d[1] = v[i].y; d[2] = v[i].z; d[3] = v[i].w; }
    LDS_WAIT(); asm volatile("" ::: "memory");
    const int c = lane & 7;
#pragma unroll
    for (int j = 0; j < 8; ++j) { const int n = (lane >> 3) + 8 * j; const LAS float* s = scr + (8 * c) * TR_LD + n;
        u32x4 o; o.x = pk2(s[0 * TR_LD], s[1 * TR_LD]); o.y = pk2(s[2 * TR_LD], s[3 * TR_LD]); o.z = pk2(s[4 * TR_LD], s[5 * TR_LD]); o.w = pk2(s[6 * TR_LD], s[7 * TR_LD]);
        *(u32x4*)(WT + (size_t)(drow0 + n) * K + k0 + 8 * c) = o; }
    LDS_WAIT(); asm volatile("" ::: "memory");
}
DI void tr_plain(const float* W, int K, int N, int Npad, bf16* WT, LAS float* scr, int r, int lane) {
    const int nblk = Npad / 64, kb = r / nblk, nb = r % nblk;
    tr_item(W, N, N, 64 * kb, 64 * nb, WT, K, 64 * nb, scr, lane);
}
DI void tr_gu(const float* W, int K, int N, int half, bf16* WT, LAS float* scr, int r, int lane) {
    const int nblk = N / 64, kb = r / nblk, nb = r % nblk, n0 = 64 * nb;
    tr_item(W, N, N, 64 * kb, n0, WT, K, (n0 >> 7) * 256 + (n0 & 127) + half * 128, scr, lane);
}
struct Ptrs {
    const float* in[20]; float* out; unsigned char* ws;
    int tid, lane, wave, bid, G;
};
DI void phase_convert_even(const Ptrs& P, LAS unsigned char* lds, int li) {
    LAS float* scr = (LAS float*)(lds + P.wave * 16640);
    const int gw = P.bid * NWAVES + P.wave, NGW = P.G * NWAVES;
    const float* w_in = P.in[1] + (size_t)li * DM * EV_N; const float* w_out = P.in[2] + (size_t)li * DM * DM;
    const float* w1 = P.in[5] + (size_t)li * DM * FF; const float* w3 = P.in[6] + (size_t)li * DM * FF; const float* w2 = P.in[7] + (size_t)li * FF * DM;
    bf16* WIN = (bf16*)(P.ws + WS_WIN); bf16* WOUT = (bf16*)(P.ws + WS_WOUT); bf16* WUP = (bf16*)(P.ws + WS_WUP); bf16* WDN = (bf16*)(P.ws + WS_WDN);
    constexpr int I_IN = (DM / 64) * (EV_NP / 64), I_OUT = (DM / 64) * (DM / 64), I_GU = (DM / 64) * (FF / 64), I_DN = (FF / 64) * (DM / 64);
    constexpr int NIT = I_IN + I_OUT + 2 * I_GU + I_DN;
    for (int it = gw; it < NIT; it += NGW) {
        int r = it;
        if (r < I_IN) { tr_plain(w_in, DM, EV_N, EV_NP, WIN, scr, r, P.lane); continue; } r -= I_IN;
        if (r < I_OUT) { tr_plain(w_out, DM, DM, DM, WOUT, scr, r, P.lane); continue; } r -= I_OUT;
        if (r < I_GU) { tr_gu(w1, DM, FF, 0, WUP, scr, r, P.lane); continue; } r -= I_GU;
        if (r < I_GU) { tr_gu(w3, DM, FF, 1, WUP, scr, r, P.lane); continue; } r -= I_GU;
        tr_plain(w2, FF, DM, DM, WDN, scr, r, P.lane);
    }
}
DI void phase_convert_odd(const Ptrs& P, LAS unsigned char* lds, int li) {
    LAS float* scr = (LAS float*)(lds + P.wave * 16640);
    const int gw = P.bid * NWAVES + P.wave, NGW = P.G * NWAVES;
    const float* w_in = P.in[10] + (size_t)li * DM * OD_N; const float* w_out = P.in[11] + (size_t)li * DM * DM;
    const float* w1 = P.in[15] + (size_t)li * NEXP * DM * FFE; const float* w3 = P.in[16] + (size_t)li * NEXP * DM * FFE; const float* w2 = P.in[17] + (size_t)li * NEXP * FFE * DM;
    bf16* WIN = (bf16*)(P.ws + WS_WIN); bf16* WOUT = (bf16*)(P.ws + WS_WOUT); bf16* WUP = (bf16*)(P.ws + WS_WUP); bf16* WDN = (bf16*)(P.ws + WS_WDN);
    constexpr int I_IN = (DM / 64) * (OD_N / 64), I_OUT = (DM / 64) * (DM / 64), I_GU = (DM / 64) * (FFE / 64), I_DN = (FFE / 64) * (DM / 64);
    constexpr int NIT = I_IN + I_OUT + NEXP * (2 * I_GU + I_DN);
    for (int it = gw; it < NIT; it += NGW) {
        int r = it;
        if (r < I_IN) { tr_plain(w_in, DM, OD_N, OD_N, WIN, scr, r, P.lane); continue; } r -= I_IN;
        if (r < I_OUT) { tr_plain(w_out, DM, DM, DM, WOUT, scr, r, P.lane); continue; } r -= I_OUT;
        const int e = r / (2 * I_GU + I_DN); r -= e * (2 * I_GU + I_DN);
        if (r < I_GU) { tr_gu(w1 + (size_t)e * DM * FFE, DM, FFE, 0, WUP + (size_t)e * 2 * FFE * DM, scr, r, P.lane); continue; } r -= I_GU;
        if (r < I_GU) { tr_gu(w3 + (size_t)e * DM * FFE, DM, FFE, 1, WUP + (size_t)e * 2 * FFE * DM, scr, r, P.lane); continue; } r -= I_GU;
        tr_plain(w2 + (size_t)e * FFE * DM, FFE, DM, DM, WDN + (size_t)e * DM * FFE, scr, r, P.lane);
    }
}
DI void phase_init(const Ptrs& P) {
    const int gw = P.bid * NWAVES + P.wave, NGW = P.G * NWAVES;
    const float* x = P.in[0]; bf16* XB = (bf16*)(P.ws + WS_XB);
    for (int m = gw; m < NTOK; m += NGW) {
        const f32x4* xr = (const f32x4*)(x + (size_t)m * DM) + P.lane; u32x2* o = (u32x2*)(XB + (size_t)m * DM) + P.lane;
#pragma unroll
        for (int j = 0; j < 4; ++j) { const f32x4 v = xr[64 * j]; u32x2 w; w.x = pk2(v.x, v.y); w.y = pk2(v.z, v.w); o[64 * j] = w; }
    }
    float* c64 = (float*)(P.ws + WS_TAB + TB_COS64); float* s64 = (float*)(P.ws + WS_TAB + TB_SIN64);
    float* c32 = (float*)(P.ws + WS_TAB + TB_COS32); float* s32 = (float*)(P.ws + WS_TAB + TB_SIN32);
    const int gt = P.bid * NTHR + P.tid, NGT = P.G * NTHR;
    for (int i = gt; i < SEQ * 32; i += NGT) { const int pos = i >> 5, j = i & 31; const float inv = exp2f(-(float)j * (13.287712379549449f / 32.0f)); const float a = (float)pos * inv; const double rv = (double)a * 0.15915494309189535; const float fr = (float)(rv - floor(rv)); c64[i] = __builtin_amdgcn_cosf(fr); s64[i] = __builtin_amdgcn_sinf(fr); }
    for (int i = gt; i < SEQ * 16; i += NGT) { const int pos = i >> 4, j = i & 15; const float inv = exp2f(-(float)j * (13.287712379549449f / 16.0f)); const float a = (float)pos * inv; const double rv = (double)a * 0.15915494309189535; const float fr = (float)(rv - floor(rv)); c32[i] = __builtin_amdgcn_cosf(fr); s32[i] = __builtin_amdgcn_sinf(fr); }
}

DI void rope_item(bf16* p, int half, float scale, const float* ct, const float* st) {
    const u32x2 a = *(const u32x2*)p, b = *(const u32x2*)(p + half);
    const f32x4 c = *(const f32x4*)ct, s = *(const f32x4*)st;
    const f32x4 x1 = {bflo(a.x), bfhi(a.x), bflo(a.y), bfhi(a.y)}, x2 = {bflo(b.x), bfhi(b.x), bflo(b.y), bfhi(b.y)};
    const f32x4 o1 = (x1 * c - x2 * s) * scale, o2 = (x1 * s + x2 * c) * scale;
    u32x2 wa, wb; wa.x = pk2(o1.x, o1.y); wa.y = pk2(o1.z, o1.w); wb.x = pk2(o2.x, o2.y); wb.y = pk2(o2.z, o2.w);
    *(u32x2*)p = wa; *(u32x2*)(p + half) = wb;
}
DI void phase_rope_even(const Ptrs& P) {
    const int gw = P.bid * NWAVES + P.wave, NGW = P.G * NWAVES;
    bf16* PROJ = (bf16*)(P.ws + WS_R1);
    const float* c64 = (const float*)(P.ws + WS_TAB + TB_COS64); const float* s64 = (const float*)(P.ws + WS_TAB + TB_SIN64);
    const float* c32 = (const float*)(P.ws + WS_TAB + TB_COS32); const float* s32 = (const float*)(P.ws + WS_TAB + TB_SIN32);
    for (int m = gw; m < NTOK; m += NGW) {
        const int pos = m & (SEQ - 1); bf16* row = PROJ + (size_t)m * EV_NP;
        for (int id = P.lane; id < 236; id += 64) {
            int col, jj, half = 32; float sc = 1.f;
            if (id < 64) { col = C_QA + (id >> 3) * 64; jj = (id & 7) * 4; sc = QSCALE; }
            else if (id < 72) { col = C_KA; jj = (id - 64) * 4; }
            else if (id < 104) { const int k = id - 72; col = C_IQ + (k >> 2) * 32; jj = (k & 3) * 4; half = 16; }
            else if (id < 108) { col = C_IK; jj = (id - 104) * 4; half = 16; }
            else if (id < 172) { const int k = id - 108; col = C_QB + (k >> 3) * 64; jj = (k & 7) * 4; sc = QSCALE; }
            else { const int k = id - 172; col = C_KB + (k >> 3) * 64; jj = (k & 7) * 4; }
            const float* ct = (half == 32) ? c64 + pos * 32 + jj : c32 + pos * 16 + jj;
            const float* st = (half == 32) ? s64 + pos * 32 + jj : s32 + pos * 16 + jj;
            rope_item(row + col + jj, half, sc, ct, st);
        }
    }
}
DI void phase_rope_odd(const Ptrs& P) {
    const int gw = P.bid * NWAVES + P.wave, NGW = P.G * NWAVES;
    bf16* PROJ = (bf16*)(P.ws + WS_R1);
    const float* c64 = (const float*)(P.ws + WS_TAB + TB_COS64); const float* s64 = (const float*)(P.ws + WS_TAB + TB_SIN64);
    for (int m = gw; m < NTOK; m += NGW) {
        const int pos = m & (SEQ - 1); bf16* row = PROJ + (size_t)m * OD_N;
#pragma unroll
        for (int r = 0; r < 4; ++r) { const int id = P.lane + 64 * r;
            const int k = id & 127, col = (id < 128 ? OC_Q : OC_K) + (k >> 3) * 64, jj = (k & 7) * 4;
            rope_item(row + col + jj, 32, id < 128 ? QSCALE : 1.f, c64 + pos * 32 + jj, s64 + pos * 32 + jj); }
    }
}

DI void ln_core(f32x4 (&v)[4], const float* g, const float* b, int lane) {
    float s = 0.f;
#pragma unroll
    for (int j = 0; j < 4; ++j) s += (v[j].x + v[j].y) + (v[j].z + v[j].w);
    const float mean = wave_sum(s) * (1.f / DM); float s2 = 0.f;
#pragma unroll
    for (int j = 0; j < 4; ++j) { v[j] = v[j] - mean; s2 += (v[j].x * v[j].x + v[j].y * v[j].y) + (v[j].z * v[j].z + v[j].w * v[j].w); }
    const float rstd = 1.f / sqrtf(wave_sum(s2) * (1.f / DM) + LN_EPS);
#pragma unroll
    for (int j = 0; j < 4; ++j) { const f32x4 gg = ((const f32x4*)g)[64 * j + lane], bb = ((const f32x4*)b)[64 * j + lane]; v[j] = v[j] * rstd * gg + bb; }
}
DI void ln_store(const f32x4 (&v)[4], float* xf, bf16* xb, int lane) {
#pragma unroll
    for (int j = 0; j < 4; ++j) { ((f32x4*)xf)[64 * j + lane] = v[j]; if (xb) { u32x2 w; w.x = pk2(v[j].x, v[j].y); w.y = pk2(v[j].z, v[j].w); ((u32x2*)xb)[64 * j + lane] = w; } }
}
template <bool ROUTER> DI void phase_ln(const Ptrs& P, LAS unsigned char* lds, const float* g, const float* b, float* xf_out, bf16* xb_out, const float* router) {
    const int gw = P.bid * NWAVES + P.wave, NGW = P.G * NWAVES;
    const float* MIX = (const float*)(P.ws + WS_MIX);
    LAS float* rl = (LAS float*)lds;
    if (ROUTER) { for (int i = P.tid; i < DM * NEXP / 4; i += NTHR) ((LAS f32x4*)rl)[i] = ((const f32x4*)router)[i]; __syncthreads(); }
    int* eid = (int*)(P.ws + WS_MISC + MS_EID); float* gate = (float*)(P.ws + WS_MISC + MS_GATE);
    for (int m = gw; m < NTOK; m += NGW) {
        f32x4 v[4];
#pragma unroll
        for (int j = 0; j < 4; ++j) v[j] = ((const f32x4*)(MIX + (size_t)m * DM))[64 * j + P.lane];
        ln_core(v, g, b, P.lane);
        ln_store(v, xf_out + (size_t)m * DM, xb_out ? xb_out + (size_t)m * DM : nullptr, P.lane);
        if (ROUTER) {
            float lg[8];
#pragma unroll
            for (int e = 0; e < 8; ++e) lg[e] = 0.f;
#pragma unroll
            for (int j = 0; j < 4; ++j)
#pragma unroll
                for (int c = 0; c < 4; ++c) { const int col = 4 * (64 * j + P.lane) + c; const f32x4 r0 = *(const LAS f32x4*)(rl + col * 8), r1 = *(const LAS f32x4*)(rl + col * 8 + 4); const float x = v[j][c];
                    lg[0] += x * r0.x; lg[1] += x * r0.y; lg[2] += x * r0.z; lg[3] += x * r0.w; lg[4] += x * r1.x; lg[5] += x * r1.y; lg[6] += x * r1.z; lg[7] += x * r1.w; }
#pragma unroll
            for (int e = 0; e < 8; ++e) lg[e] = wave_sum(lg[e]);
            int i1 = 0; float v1 = lg[0];
#pragma unroll
            for (int e = 1; e < 8; ++e) if (lg[e] > v1) { v1 = lg[e]; i1 = e; }
            int i2 = -1; float v2 = -INFINITY;
#pragma unroll
            for (int e = 0; e < 8; ++e) if (e != i1 && lg[e] > v2) { v2 = lg[e]; i2 = e; }
            const float ex = expf(v2 - v1), g1 = 1.f / (1.f + ex), g2 = ex / (1.f + ex);
            if (P.lane == 0) { eid[2 * m] = i1; eid[2 * m + 1] = i2; gate[2 * m] = g1; gate[2 * m + 1] = g2; }
        }
    }
}

DI void phase_route(const Ptrs& P, LAS unsigned char* lds) {
    const int* eid = (const int*)(P.ws + WS_MISC + MS_EID);
    int* rowof = (int*)(P.ws + WS_MISC + MS_ROWOF); int* pblk = (int*)(P.ws + WS_MISC + MS_PBLK);
    const bf16* XB = (const bf16*)(P.ws + WS_XB); bf16* XBUF = (bf16*)(P.ws + WS_XBUF);
    LAS int* cl = (LAS int*)lds;
    for (int c = P.bid; c < NTOK / 64; c += P.G) {
        __syncthreads();
        if (P.tid < 32) cl[P.tid] = 0;
        __syncthreads();
        int tot[8], bef[8];
#pragma unroll
        for (int e = 0; e < 8; ++e) { tot[e] = 0; bef[e] = 0; }
        const int a0 = 128 * c;
        for (int k = 0; k < 64; ++k) { const int a = P.tid + NTHR * k; const int e = eid[a]; const int pre = (a < a0) ? 1 : 0;
#pragma unroll
            for (int x = 0; x < 8; ++x) { const int hit = (e == x) ? 1 : 0; tot[x] += hit; bef[x] += hit & pre; } }
#pragma unroll
        for (int x = 0; x < 8; ++x) {
            int t = tot[x], q = bef[x];
#pragma unroll
            for (int o = 1; o < 64; o <<= 1) { t += __shfl_xor(t, o); q += __shfl_xor(q, o); }
            if (P.lane == 0) { __hip_atomic_fetch_add(&cl[x], t, __ATOMIC_RELAXED, __HIP_MEMORY_SCOPE_WORKGROUP); __hip_atomic_fetch_add(&cl[8 + x], q, __ATOMIC_RELAXED, __HIP_MEMORY_SCOPE_WORKGROUP); }
        }
        __syncthreads();
        if (P.tid == 0) { int acc = 0; for (int e = 0; e < 8; ++e) { cl[16 + e] = acc; acc += (cl[e] + 255) >> 8; } cl[24] = acc; }
        __syncthreads();
        if (P.wave == 0) {
            int run[8];
#pragma unroll
            for (int x = 0; x < 8; ++x) run[x] = 0;
            const unsigned long long lt = (P.lane == 0) ? 0ull : (~0ull >> (64 - P.lane));
#pragma unroll
            for (int h = 0; h < 2; ++h) { const int i = 64 * h + P.lane; const int e = eid[a0 + i]; int dest = 0;
#pragma unroll
                for (int x = 0; x < 8; ++x) { const unsigned long long mk = __ballot(e == x); if (e == x) dest = 256 * cl[16 + x] + cl[8 + x] + run[x] + __builtin_popcountll(mk & lt); run[x] += __builtin_popcountll(mk); }
                cl[32 + i] = dest; rowof[a0 + i] = dest; }
        }
        if (c == 0 && P.tid < 9) pblk[P.tid] = cl[16 + P.tid];
        __syncthreads();
        for (int i = P.wave; i < 128; i += NWAVES) { const int dest = cl[32 + i]; const int t = (a0 + i) >> 1;
            const u32x4* s = (const u32x4*)(XB + (size_t)t * DM) + 2 * P.lane; u32x4* d = (u32x4*)(XBUF + (size_t)dest * DM) + 2 * P.lane;
            const u32x4 v0 = s[0], v1 = s[1]; d[0] = v0; d[1] = v1; }
    }
}
DI void phase_moe_combine(const Ptrs& P, const float* g, const float* b, float* xf_out, bf16* xb_out) {
    const int gw = P.bid * NWAVES + P.wave, NGW = P.G * NWAVES;
    const float* XF = (const float*)(P.ws + WS_XF); const float* Y = (const float*)(P.ws + WS_MIX);
    const int* rowof = (const int*)(P.ws + WS_MISC + MS_ROWOF); const float* gate = (const float*)(P.ws + WS_MISC + MS_GATE);
    for (int m = gw; m < NTOK; m += NGW) {
        const int r0 = rowof[2 * m], r1 = rowof[2 * m + 1]; const float g0 = gate[2 * m], g1 = gate[2 * m + 1];
        f32x4 v[4];
#pragma unroll
        for (int j = 0; j < 4; ++j) { const f32x4 x = ((const f32x4*)(XF + (size_t)m * DM))[64 * j + P.lane], y0 = ((const f32x4*)(Y + (size_t)r0 * DM))[64 * j + P.lane], y1 = ((const f32x4*)(Y + (size_t)r1 * DM))[64 * j + P.lane];
            v[j] = ALPHA * x + (g0 * y0 + g1 * y1); }
        ln_core(v, g, b, P.lane);
        ln_store(v, xf_out + (size_t)m * DM, xb_out ? xb_out + (size_t)m * DM : nullptr, P.lane);
    }
}

constexpr int SC_LD = 2052;
DI unsigned fkey(float f) { const unsigned u = __builtin_bit_cast(unsigned, f); return (u & 0x80000000u) ? ~u : (u | 0x80000000u); }
DI int wave_sum_i(int v) {
    v += __builtin_amdgcn_update_dpp(0, v, 0xB1, 0xf, 0xf, true);
    v += __builtin_amdgcn_update_dpp(0, v, 0x4E, 0xf, 0xf, true);
    v += __builtin_amdgcn_update_dpp(0, v, 0x141, 0xf, 0xf, true);
    v += __builtin_amdgcn_update_dpp(0, v, 0x140, 0xf, 0xf, true);
    return __builtin_amdgcn_readlane(v, 0) + __builtin_amdgcn_readlane(v, 16) + __builtin_amdgcn_readlane(v, 32) + __builtin_amdgcn_readlane(v, 48);
}
DI void idx_unit(const Ptrs& P, LAS unsigned char* lds, int b, int qb16) {
    const bf16* PROJ = (const bf16*)(P.ws + WS_R1); unsigned* MASK = (unsigned*)(P.ws + WS_MASK);
    LAS float* sc = (LAS float*)lds;
    const int t0 = 16 * qb16, lane = P.lane, l15 = lane & 15, l4 = lane >> 4; const size_t rowbase = (size_t)b * SEQ;
    __syncthreads();
#ifndef IDX_REP_SCORE
#define IDX_REP_SCORE 1
#endif
#ifndef IDX_REP_SEL
#define IDX_REP_SEL 1
#endif
    for (int rep_ = 0; rep_ < IDX_REP_SCORE; ++rep_)
    {
        const bf16* qrow = PROJ + (rowbase + t0 + l15) * EV_NP;
        const int nkt = qb16 + 1;
        bf16x8 ak[16];
#pragma unroll
        for (int i = 0; i < 16; ++i) { const int kt = P.wave + 8 * i; const int ktc = kt < nkt ? kt : nkt - 1; ak[i] = *(const bf16x8*)(PROJ + (rowbase + 16 * ktc + l15) * EV_NP + C_IK + 8 * l4); }
#pragma unroll
        for (int i = 0; i < 16; ++i) asm volatile("" : "+v"(ak[i]));
        bf16x8 bq[8];
#pragma unroll
        for (int h = 0; h < 8; ++h) bq[h] = *(const bf16x8*)(qrow + C_IQ + h * 32 + 8 * l4);
        const u32x4 wraw = *(const u32x4*)(qrow + C_IW); float wv[8];
        const float WS = 0.17677669529663687f * 0.35355339059327373f;
        wv[0] = bflo(wraw.x) * WS; wv[1] = bfhi(wraw.x) * WS; wv[2] = bflo(wraw.y) * WS; wv[3] = bfhi(wraw.y) * WS; wv[4] = bflo(wraw.z) * WS; wv[5] = bfhi(wraw.z) * WS; wv[6] = bflo(wraw.w) * WS; wv[7] = bfhi(wraw.w) * WS;
#pragma unroll
        for (int i = 0; i < 16; ++i) { const int kt = P.wave + 8 * i;
            if (kt < nkt) {
                f32x4 s = {0.f, 0.f, 0.f, 0.f};
#pragma unroll
                for (int h = 0; h < 8; ++h) { const f32x4 z = {0.f, 0.f, 0.f, 0.f}; const f32x4 d = __builtin_amdgcn_mfma_f32_16x16x32_bf16(ak[i], bq[h], z, 0, 0, 0);
                    s.x += wv[h] * fmaxf(d.x, 0.f); s.y += wv[h] * fmaxf(d.y, 0.f); s.z += wv[h] * fmaxf(d.z, 0.f); s.w += wv[h] * fmaxf(d.w, 0.f); }
                if (kt == nkt - 1) { const int kq = 4 * l4; if (kq + 0 > l15) s.x = -INFINITY; if (kq + 1 > l15) s.y = -INFINITY; if (kq + 2 > l15) s.z = -INFINITY; if (kq + 3 > l15) s.w = -INFINITY; }
                *(LAS f32x4*)(sc + l15 * SC_LD + 16 * kt + 4 * l4) = s;
            } }
    }
    __syncthreads();
    const unsigned long long ltm = (lane == 0) ? 0ull : (~0ull >> (64 - lane));
    for (int rr_ = 0; rr_ < 2 * IDX_REP_SEL; ++rr_) { const int rr = rr_ & 1;
        const int r = 2 * P.wave + rr, t = t0 + r; const int jmax = (t >> 6) + 1;
        unsigned key[32];
#pragma unroll
        for (int j = 0; j < 32; ++j) { const int idx = 64 * j + lane; const float f = sc[r * SC_LD + idx]; key[j] = (idx <= t) ? fkey(f) : 0u; }
        unsigned T = 0u; int need = 0; bool plain = true;
        const bool all = (t + 1 <= 256);
        if (!all) {
            bool exact = false;
            for (int bit = 31; bit >= 0 && !exact; --bit) { const unsigned cand = T | (1u << bit); int cs = 0, cv = 0;
#pragma unroll
                for (int jc = 0; jc < 4; ++jc) if (8 * jc < jmax) {
#pragma unroll
                    for (int j = 8 * jc; j < 8 * jc + 8; ++j) { if (j & 1) cv += (key[j] >= cand) ? 1 : 0; else cs += __builtin_popcountll(__ballot(key[j] >= cand)); if ((j & 3) == 3) __builtin_amdgcn_sched_barrier(0); } }
                const int cnt = cs + wave_sum_i(cv);
                if (cnt >= 256) { T = cand; exact = (cnt == 256); } }
            if (!exact) {
                int cg = 0, ce = 0;
#pragma unroll
                for (int j = 0; j < 32; ++j) { cg += (key[j] > T) ? 1 : 0; ce += (key[j] == T) ? 1 : 0; }
                const int ngt = wave_sum_i(cg), neq = wave_sum_i(ce);
                need = 256 - ngt; plain = (neq == need); }
        } else T = 1u;
        unsigned myw = 0u;
        if (plain) {
#pragma unroll
            for (int j = 0; j < 32; ++j) { const unsigned long long sm = __ballot(key[j] >= T);
                if (lane == 2 * j) myw = (unsigned)sm;
                if (lane == 2 * j + 1) myw = (unsigned)(sm >> 32);
                __builtin_amdgcn_sched_barrier(0); }
        } else {
            int run = 0;
#pragma unroll
            for (int j = 0; j < 32; ++j) { const bool eq = key[j] == T; const unsigned long long em = __ballot(eq); const int rank = run + __builtin_popcountll(em & ltm);
                const unsigned long long sm = __ballot(key[j] > T || (eq && rank < need)); run += __builtin_popcountll(em);
                if (lane == 2 * j) myw = (unsigned)sm;
                if (lane == 2 * j + 1) myw = (unsigned)(sm >> 32);
                __builtin_amdgcn_sched_barrier(0); }
        }
        MASK[(rowbase + t) * 64 + lane] = myw;
    }
}
DI void kmean_unit(const Ptrs& P, LAS unsigned char* lds, int b, int h, int n) {
    const bf16* PROJ = (const bf16*)(P.ws + WS_R1); bf16* KM = (bf16*)(P.ws + WS_MISC + MS_KM);
    LAS float* red = (LAS float*)lds;
    const int rg = P.tid >> 3, c = P.tid & 7; const bf16* p = PROJ + ((size_t)b * SEQ + 256 * n + 4 * rg) * EV_NP + C_KB + h * 64 + 8 * c;
    u32x4 v[4];
#pragma unroll
    for (int i = 0; i < 4; ++i) v[i] = *(const u32x4*)(p + (size_t)i * EV_NP);
    float s[8];
#pragma unroll
    for (int e = 0; e < 8; ++e) s[e] = 0.f;
#pragma unroll
    for (int i = 0; i < 4; ++i) { s[0] += bflo(v[i].x); s[1] += bfhi(v[i].x); s[2] += bflo(v[i].y); s[3] += bfhi(v[i].y); s[4] += bflo(v[i].z); s[5] += bfhi(v[i].z); s[6] += bflo(v[i].w); s[7] += bfhi(v[i].w); }
    __syncthreads();
#pragma unroll
    for (int e = 0; e < 8; ++e) red[rg * 65 + 8 * c + e] = s[e];
    __syncthreads();
    if (P.tid < 64) { float t = 0.f;
#pragma unroll 8
        for (int g = 0; g < 64; ++g) t += red[g * 65 + P.tid];
        KM[(((size_t)b * 8 + h) * 8 + n) * 64 + P.tid] = (bf16)f2bf(t * (1.f / 256.f)); }
}
DI void phase_index(const Ptrs& P, LAS unsigned char* lds) {
    for (int u = P.bid; u < 512; u += P.G) kmean_unit(P, lds, u & 7, (u >> 3) & 7, u >> 6);
    for (int k = 0; ; ++k) { const int u = P.bid + P.G * k; if (u >= 1024) break;
        const int b = u & 7, v = u >> 3, kq = v >> 5, a = v & 31; const int idx = (kq == 0) ? a : (kq == 1) ? 127 - a : (kq == 2) ? 32 + a : 95 - a;
        idx_unit(P, lds, b, idx); }
}

constexpr int KROW = 144;
constexpr float M_INIT = -1.0e30f;
DI f32x16 mfma32(bf16x8 a, bf16x8 b, f32x16 c) { return __builtin_amdgcn_mfma_f32_32x32x16_bf16(a, b, c, 0, 0, 0); }
typedef short v4i16_t __attribute__((ext_vector_type(4)));
DI s16x4 vtr(const LAS unsigned char* p) { return __builtin_bit_cast(s16x4, __builtin_amdgcn_ds_read_tr16_b64_v4i16((LAS v4i16_t*)p)); }
typedef __bf16 bf16x2_t __attribute__((ext_vector_type(2)));
DI unsigned cvtpk(float lo, float hi) { const f32x2 v = {lo, hi}; const bf16x2_t b = __builtin_convertvector(v, bf16x2_t); return __builtin_bit_cast(unsigned, b); }
DI void swap32(unsigned& a, unsigned& b) { asm volatile("s_nop 1\n\tv_permlane32_swap_b32 %0, %1\n\ts_nop 1" : "+v"(a), "+v"(b)); }
DI float xhalf_max(float m) { unsigned a = __builtin_bit_cast(unsigned, m), b = a; swap32(a, b); return fmaxf(__builtin_bit_cast(float, a), __builtin_bit_cast(float, b)); }
DI float xhalf_sum(float m) { unsigned a = __builtin_bit_cast(unsigned, m), b = a; swap32(a, b); return __builtin_bit_cast(float, a) + __builtin_bit_cast(float, b); }
DI int crow(int r, int hi) { return (r & 3) + 8 * (r >> 2) + 4 * hi; }

struct AState { float m, l; f32x16 o0, o1; };
DI void astate_init(AState& s) { s.m = M_INIT; s.l = 0.f;
#pragma unroll
    for (int r = 0; r < 16; ++r) { s.o0[r] = 0.f; s.o1[r] = 0.f; } }

template <class MaskF>
DI void attn_tile(AState& st, const LAS unsigned char* kt, const LAS unsigned char* vt, int vd0, const bf16x8 (&qr)[4], LAS float* wsf, int lane, const f32x16& c0, const f32x16& c1, MaskF&& mask) {
    const int r32 = lane & 31, hi = lane >> 5;
    f32x16 p0 = c0, p1 = c1;
    const LAS unsigned char* kb = kt + r32 * KROW + hi * 16;
#pragma unroll
    for (int d0 = 0; d0 < 4; ++d0) { const bf16x8 a0 = *(const LAS bf16x8*)(kb + d0 * 32), a1 = *(const LAS bf16x8*)(kb + 32 * KROW + d0 * 32);
        p0 = mfma32(a0, qr[d0], p0); p1 = mfma32(a1, qr[d0], p1); }
    mask(p0, p1);
    float rm = fmaxf(p0[0], p1[0]);
#pragma unroll
    for (int r = 1; r < 16; ++r) rm = fmaxf(rm, fmaxf(p0[r], p1[r]));
    rm = xhalf_max(rm);
    if (__any(rm > st.m)) {
        const float mn = fmaxf(st.m, rm), al = __builtin_amdgcn_exp2f(st.m - mn); st.l *= al; st.m = mn;
        if (hi == 0) wsf[r32] = al;
        asm volatile("s_waitcnt lgkmcnt(0)" ::: "memory");
#pragma unroll
        for (int g = 0; g < 4; ++g) { const f32x4 a4 = *(const LAS f32x4*)(wsf + 8 * g + 4 * hi);
#pragma unroll
            for (int i = 0; i < 4; ++i) { st.o0[4 * g + i] *= a4[i]; st.o1[4 * g + i] *= a4[i]; } }
    }
    float sacc = 0.f;
#pragma unroll
    for (int r = 0; r < 16; ++r) { p0[r] = __builtin_amdgcn_exp2f(p0[r] - st.m); p1[r] = __builtin_amdgcn_exp2f(p1[r] - st.m); sacc += p0[r] + p1[r]; }
    st.l += sacc;
    const LAS unsigned char* vb = vt + (4 * hi + ((lane & 15) >> 2)) * 64 + ((lane >> 4) & 1) * 32 + (lane & 3) * 8;
#pragma unroll
    for (int sub = 0; sub < 2; ++sub)
#pragma unroll
        for (int ks = 0; ks < 2; ++ks) {
            u32x4 pw;
            if (sub == 0) { pw.x = cvtpk(p0[8 * ks], p0[8 * ks + 1]); pw.y = cvtpk(p0[8 * ks + 2], p0[8 * ks + 3]); pw.z = cvtpk(p0[8 * ks + 4], p0[8 * ks + 5]); pw.w = cvtpk(p0[8 * ks + 6], p0[8 * ks + 7]); }
            else          { pw.x = cvtpk(p1[8 * ks], p1[8 * ks + 1]); pw.y = cvtpk(p1[8 * ks + 2], p1[8 * ks + 3]); pw.z = cvtpk(p1[8 * ks + 4], p1[8 * ks + 5]); pw.w = cvtpk(p1[8 * ks + 6], p1[8 * ks + 7]); }
            const bf16x8 pa = __builtin_bit_cast(bf16x8, pw);
            const LAS unsigned char* vr = vb + (32 * sub + 16 * ks) * 64;
            { const s16x4 lo = vtr(vr), hh = vtr(vr + 8 * 64); const bf16x8 vf = {lo[0], lo[1], lo[2], lo[3], hh[0], hh[1], hh[2], hh[3]}; st.o0 = mfma32(pa, vf, st.o0); }
            { const s16x4 lo = vtr(vr + vd0), hh = vtr(vr + vd0 + 8 * 64); const bf16x8 vf = {lo[0], lo[1], lo[2], lo[3], hh[0], hh[1], hh[2], hh[3]}; st.o1 = mfma32(pa, vf, st.o1); }
        }
}
template <class RowF>
DI float attn_finish(AState& st, LAS float* wsf, int lane, RowF&& rowp) {
    const int r32 = lane & 31, hi = lane >> 5;
    const float lt = xhalf_sum(st.l);
    if (hi == 0) wsf[32 + r32] = lt;
    asm volatile("s_waitcnt lgkmcnt(0)" ::: "memory");
#pragma unroll
    for (int g = 0; g < 4; ++g) { const f32x4 l4 = *(const LAS f32x4*)(wsf + 32 + 8 * g + 4 * hi);
#pragma unroll
        for (int i = 0; i < 4; ++i) { const float inv = 1.0f / l4[i]; bf16* o = rowp(8 * g + 4 * hi + i);
#ifdef DBG_L
            { const float L = l4[i]; const float a0 = st.o0[4 * g + i], a1 = st.o1[4 * g + i]; const bool obad = !(fabsf(a0) < 1e30f) || !(fabsf(a1) < 1e30f);
              const float c = (L == 0.f) ? 32.f : (L != L) ? 512.f : (fabsf(L) > 1e30f) ? 128.f : (L < 0.99f) ? 2048.f : obad ? 8192.f : 0.f; o[r32] = (bf16)f2bf(c); o[32 + r32] = (bf16)f2bf(c); }
#else
            o[r32] = (bf16)f2bf(st.o0[4 * g + i] * inv); o[32 + r32] = (bf16)f2bf(st.o1[4 * g + i] * inv);
#endif
            } }
    return lt;
}
struct TileRegs { u32x4 k, v; };
DI void tile_load(TileRegs& r, const bf16* krow, const bf16* vrow, int chunk) { r.k = *(const u32x4*)(krow + chunk * 8); r.v = *(const u32x4*)(vrow + chunk * 8); }
DI void tile_store(LAS unsigned char* kt, LAS unsigned char* vt, int vd0, const TileRegs& r, int key, int chunk) {
    *(LAS u32x4*)(kt + key * KROW + chunk * 16) = r.k;
    *(LAS u32x4*)(vt + (chunk >> 2) * vd0 + key * 64 + (chunk & 3) * 16) = r.v;
}
constexpr int AT_K = 64 * KROW, AT_V = 2 * 64 * 64, AT_BUF = AT_K + AT_V;
constexpr int AT_WSF = 2 * AT_BUF;
constexpr int AT_EXTRA = AT_WSF + NWAVES * 256;
DI void load_q(bf16x8 (&qr)[4], const bf16* qrowp  , int hi) {
#pragma unroll
    for (int d0 = 0; d0 < 4; ++d0) qr[d0] = *(const bf16x8*)(qrowp + d0 * 16 + hi * 8);
}
template <class KV, class Act, class TileC, class MaskT>
DI void attn_run(AState& st, LAS unsigned char* lds, const bf16x8 (&qr)[4], int nt, int tid, int lane, int wave, KV&& kv, Act&& act, TileC&& tilec, MaskT&& mask) {
    const int key = tid >> 3, chunk = tid & 7;
    LAS unsigned char* buf0 = lds; LAS unsigned char* buf1 = lds + AT_BUF; LAS float* wsf = (LAS float*)(lds + AT_WSF) + wave * 64;
    TileRegs trA, trB; const bf16* kp; const bf16* vp;
    kv(0, key, kp, vp); tile_load(trA, kp, vp, chunk); tile_store(buf0, buf0 + AT_K, 4096, trA, key, chunk);
    if (nt > 1) { kv(1, key, kp, vp); tile_load(trA, kp, vp, chunk); }
    __syncthreads();
    for (int t = 0; t < nt; t += 2) {
        {   if (t + 2 < nt) { kv(t + 2, key, kp, vp); tile_load(trB, kp, vp, chunk); }
            if (act(t)) { f32x16 c0, c1; tilec(t, c0, c1); attn_tile(st, buf0, buf0 + AT_K, 4096, qr, wsf, lane, c0, c1, [&](f32x16& p0, f32x16& p1) { mask(t, p0, p1); }); }
            if (t + 1 < nt) tile_store(buf1, buf1 + AT_K, 4096, trA, key, chunk);
            __syncthreads(); }
        if (t + 1 < nt) { const int t1 = t + 1;
            if (t1 + 2 < nt) { kv(t1 + 2, key, kp, vp); tile_load(trA, kp, vp, chunk); }
            if (act(t1)) { f32x16 c0, c1; tilec(t1, c0, c1); attn_tile(st, buf1, buf1 + AT_K, 4096, qr, wsf, lane, c0, c1, [&](f32x16& p0, f32x16& p1) { mask(t1, p0, p1); }); }
            if (t1 + 1 < nt) tile_store(buf0, buf0 + AT_K, 4096, trB, key, chunk);
            __syncthreads(); }
    }
}
DI void fill16(f32x16& c, float v) {
#pragma unroll
    for (int r = 0; r < 16; ++r) c[r] = v;
}
#define CR(r) (((r) & 3) + 8 * ((r) >> 2))
DI void dsa_unit(const Ptrs& P, LAS unsigned char* lds, int b, int qb32) {
    const bf16* PROJ = (const bf16*)(P.ws + WS_R1); const unsigned* MASK = (const unsigned*)(P.ws + WS_MASK); bf16* O = (bf16*)(P.ws + WS_O);
    const int lane = P.lane, r32 = lane & 31, hi = lane >> 5, t0 = 32 * qb32; const size_t rowbase = (size_t)b * SEQ;
    LAS unsigned* ml = (LAS unsigned*)(lds + AT_EXTRA);
#pragma unroll
    for (int k = 0; k < 4; ++k) { const int idx = P.tid + NTHR * k, row = idx >> 6, j = idx & 63; ml[j * 33 + row] = MASK[(rowbase + t0 + row) * 64 + j]; }
    bf16x8 qr[4]; load_q(qr, PROJ + (rowbase + t0 + r32) * EV_NP + C_QA + P.wave * 64, hi);
    AState st; astate_init(st);
    const int nt = (t0 + 32 + 63) >> 6;
    attn_run(st, lds, qr, nt, P.tid, lane, P.wave,
        [&](int t, int key, const bf16*& kp, const bf16*& vp) { const bf16* rp = PROJ + (rowbase + 64 * t + key) * EV_NP; kp = rp + C_KA; vp = rp + C_VA; },
        [&](int) { return true; },
        [&](int, f32x16& c0, f32x16& c1) { fill16(c0, 0.f); fill16(c1, 0.f); },
        [&](int t, f32x16& p0, f32x16& p1) { const unsigned w0 = ml[(2 * t) * 33 + r32] >> (4 * hi), w1 = ml[(2 * t + 1) * 33 + r32] >> (4 * hi);
#pragma unroll
            for (int r = 0; r < 16; ++r) { if (!((w0 >> CR(r)) & 1u)) p0[r] = -INFINITY; if (!((w1 >> CR(r)) & 1u)) p1[r] = -INFINITY; } });
    LAS float* wsf = (LAS float*)(lds + AT_WSF) + P.wave * 64;
    (void)attn_finish(st, wsf, lane, [&](int rr) { return O + (rowbase + t0 + rr) * DM + P.wave * 64; });
}
DI void moba_unit(const Ptrs& P, LAS unsigned char* lds, int b, int h, int n) {
    const bf16* PROJ = (const bf16*)(P.ws + WS_R1); const bf16* KM = (const bf16*)(P.ws + WS_MISC + MS_KM); bf16* O = (bf16*)(P.ws + WS_O);
    const int lane = P.lane, r32 = lane & 31, hi = lane >> 5; const size_t rowbase = (size_t)b * SEQ; const int q0 = 256 * n + 32 * P.wave;
    bf16x8 qr[4]; load_q(qr, PROJ + (rowbase + q0 + r32) * EV_NP + C_QB + h * 64, hi);
    unsigned sel = 0u;
    if (n > 0) {
        f32x16 g;
#pragma unroll
        for (int r = 0; r < 16; ++r) g[r] = 0.f;
        const bf16* kmr = KM + (((size_t)b * 8 + h) * 8 + (r32 & 7)) * 64;
#pragma unroll
        for (int d0 = 0; d0 < 4; ++d0) { bf16x8 a = *(const bf16x8*)(kmr + d0 * 16 + hi * 8); if (r32 >= 8) a = (bf16x8){0, 0, 0, 0, 0, 0, 0, 0}; g = mfma32(a, qr[d0], g); }
        float gt[8];
#pragma unroll
        for (int i = 0; i < 4; ++i) { const float own = g[i], oth = __shfl_xor(own, 32); gt[i] = hi ? oth : own; gt[4 + i] = hi ? own : oth; }
#pragma unroll
        for (int round = 0; round < 3; ++round) if (round < n) { float best = -INFINITY; int bi = -1;
#pragma unroll
            for (int j = 0; j < 8; ++j) if (j < n && !((sel >> j) & 1u) && gt[j] > best) { best = gt[j]; bi = j; }
            if (bi >= 0) sel |= 1u << bi; }
    }
    AState st; astate_init(st);
    const int nt = 4 * n + 4;
    attn_run(st, lds, qr, nt, P.tid, lane, P.wave,
        [&](int t, int key, const bf16*& kp, const bf16*& vp) { const bf16* rp = PROJ + (rowbase + 64 * t + key) * EV_NP + h * 64; kp = rp + C_KB; vp = rp + C_VB; },
        [&](int t) { const int blk = t >> 2; if (blk < n) return __any((sel >> blk) & 1u) != 0; return 64 * (t - 4 * n) <= 32 * P.wave + 31; },
        [&](int t, f32x16& c0, f32x16& c1) { const int blk = t >> 2; const float cv = (blk >= n || ((sel >> blk) & 1u)) ? 0.f : -INFINITY; fill16(c0, cv); fill16(c1, cv); },
        [&](int t, f32x16& p0, f32x16& p1) { const int ot = t - 4 * n;
            if (ot >= 0 && 64 * ot + 63 > 32 * P.wave) { const int kb = 64 * ot + 4 * hi, qrel = 32 * P.wave + r32;
#pragma unroll
                for (int r = 0; r < 16; ++r) { if (kb + CR(r) > qrel) p0[r] = -INFINITY; if (kb + 32 + CR(r) > qrel) p1[r] = -INFINITY; } } });
    LAS float* wsf = (LAS float*)(lds + AT_WSF) + P.wave * 64;
    (void)attn_finish(st, wsf, lane, [&](int rr) { return O + (rowbase + q0 + rr) * DM + 512 + h * 64; });
}
DI void phase_attn_even(const Ptrs& P, LAS unsigned char* lds) {
    for (int k = 0; ; ++k) { const int u = P.bid + P.G * k; if (u >= 512) break;
        const int b = u & 7, v = u >> 3, a = v & 31; dsa_unit(P, lds, b, (v >> 5) ? 63 - a : a); }
    for (int k = 0; ; ++k) { const int u = P.bid + P.G * k; if (u >= 512) break;
        const int b = u & 7, h = (u >> 3) & 7, v = u >> 6; moba_unit(P, lds, b, h, v < 4 ? v : 11 - v); }
}
constexpr int B3_K = 128 * KROW, B3_V = 2 * 128 * 64, B3_HALF = B3_K + B3_V, B3_WSF = 2 * B3_HALF;
DI void b3_unit(const Ptrs& P, LAS unsigned char* lds, int b, int h, int rp) {
    const bf16* PROJ = (const bf16*)(P.ws + WS_R1); bf16* O = (bf16*)(P.ws + WS_O); float* LSE3 = (float*)(P.ws + WS_MISC + MS_LSE3);
    const int lane = P.lane, r32 = lane & 31, hi = lane >> 5, half = P.wave >> 2, wi = P.wave & 3, r16 = 2 * rp + half; const size_t rowbase = (size_t)b * SEQ;
    LAS unsigned char* kh = lds + half * B3_HALF; LAS unsigned char* vh = kh + B3_K;
    const int th = P.tid & 255;
#pragma unroll
    for (int k = 0; k < 4; ++k) { const int idx = th + 256 * k, key = idx >> 3, chunk = idx & 7; const bf16* rpn = PROJ + (rowbase + 16 * key + r16) * OD_N + h * 64;
        TileRegs tr; tile_load(tr, rpn + OC_K, rpn + OC_V, chunk); tile_store(kh, vh, 128 * 64, tr, key, chunk); }
    bf16x8 qr[4]; load_q(qr, PROJ + (rowbase + 16 * (32 * wi + r32) + r16) * OD_N + OC_Q + h * 64, hi);
    __syncthreads();
    AState st; astate_init(st);
    LAS float* wsf = (LAS float*)(lds + B3_WSF) + P.wave * 64;
    f32x16 zc; fill16(zc, 0.f);
    for (int T = 0; T <= (wi >> 1); ++T)
        attn_tile(st, kh + 64 * T * KROW, vh + 64 * T * 64, 128 * 64, qr, wsf, lane, zc, zc, [&](f32x16& p0, f32x16& p1) { const int kb = 64 * T + 4 * hi, wq = 32 * wi + r32;
#pragma unroll
            for (int r = 0; r < 16; ++r) { if (kb + CR(r) > wq) p0[r] = -INFINITY; if (kb + 32 + CR(r) > wq) p1[r] = -INFINITY; } });
    const float lt = attn_finish(st, wsf, lane, [&](int rr) { return O + (rowbase + 16 * (32 * wi + rr) + r16) * DM + h * 64; });
    if (hi == 0) LSE3[(rowbase + 16 * (32 * wi + r32) + r16) * 16 + h] = st.m + __builtin_amdgcn_logf(lt);
    __syncthreads();
}
DI void phase_b3(const Ptrs& P, LAS unsigned char* lds) {
    for (int k = 0; ; ++k) { const int u = P.bid + P.G * k; if (u >= 1024) break; b3_unit(P, lds, u & 7, (u >> 3) & 15, u >> 7); }
}
DI void band_unit(const Ptrs& P, LAS unsigned char* lds, int b, int h, int qb) {
    const bf16* PROJ = (const bf16*)(P.ws + WS_R1); bf16* O = (bf16*)(P.ws + WS_O); const float* LSE3 = (const float*)(P.ws + WS_MISC + MS_LSE3);
    const int lane = P.lane, r32 = lane & 31, hi = lane >> 5; const size_t rowbase = (size_t)b * SEQ; const int t0w = 256 * qb + 32 * P.wave;
    bf16x8 qr[4]; load_q(qr, PROJ + (rowbase + t0w + r32) * OD_N + OC_Q + h * 64, hi);
    AState st; st.m = LSE3[(rowbase + t0w + r32) * 16 + h]; st.l = hi ? 0.f : 1.f;
#pragma unroll
    for (int r = 0; r < 16; ++r) { const bf16* orow = O + (rowbase + t0w + CR(r) + 4 * hi) * DM + h * 64 + r32; st.o0[r] = bf2f(orow[0]); st.o1[r] = bf2f(orow[32]); }
    const int kt_lo = (4 * qb - 8 > 0) ? 4 * qb - 8 : 0, nt = 4 * qb + 4 - kt_lo;
    attn_run(st, lds, qr, nt, P.tid, lane, P.wave,
        [&](int t, int key, const bf16*& kp, const bf16*& vp) { const bf16* rp = PROJ + (rowbase + 64 * (kt_lo + t) + key) * OD_N + h * 64; kp = rp + OC_K; vp = rp + OC_V; },
        [&](int t) { const int k0 = 64 * (kt_lo + t); return (k0 + 63 >= t0w - 512) && (k0 <= t0w + 31); },
        [&](int t, f32x16& c0, f32x16& c1) { const int D0 = t0w - 64 * (kt_lo + t);
#pragma unroll
            for (int sub = 0; sub < 2; ++sub) { const int D = D0 - 32 * sub; f32x16& c = sub ? c1 : c0;
                if (D >= 32 && D <= 96) {
#pragma unroll
                    for (int r = 0; r < 16; ++r) c[r] = ((r & 3) == (r32 & 3)) ? 1.0f : 0.0f; }
                else if (D >= 160 && D <= 480) {
#pragma unroll
                    for (int r = 0; r < 16; ++r) c[r] = ((r & 3) == (r32 & 3)) ? 0.0f : -INFINITY; }
                else if (D < 0 || D > 512) fill16(c, -INFINITY);
                else fill16(c, 0.f); } },
        [&](int t, f32x16& p0, f32x16& p1) { const int D0 = t0w - 64 * (kt_lo + t); const int dq = D0 + r32 - 4 * hi;
            if (D0 == 0 || D0 == 128 || D0 == 512) {
#pragma unroll
                for (int r = 0; r < 16; ++r) { const int d = dq - CR(r); const int mult = ((unsigned)d <= 128u ? 1 : 0) + (((unsigned)d <= 512u && (d & 3) == 0) ? 1 : 0); p0[r] = mult == 0 ? -INFINITY : (mult == 2 ? p0[r] + 1.0f : p0[r]); } }
            if (D0 == 32 || D0 == 160 || D0 == 544) {
#pragma unroll
                for (int r = 0; r < 16; ++r) { const int d = dq - 32 - CR(r); const int mult = ((unsigned)d <= 128u ? 1 : 0) + (((unsigned)d <= 512u && (d & 3) == 0) ? 1 : 0); p1[r] = mult == 0 ? -INFINITY : (mult == 2 ? p1[r] + 1.0f : p1[r]); } } });
    LAS float* wsf = (LAS float*)(lds + AT_WSF) + P.wave * 64;
    (void)attn_finish(st, wsf, lane, [&](int rr) { return O + (rowbase + t0w + rr) * DM + h * 64; });
}
DI void phase_band(const Ptrs& P, LAS unsigned char* lds) {
    for (int k = 0; ; ++k) { const int u = P.bid + P.G * k; if (u >= 1024) break; band_unit(P, lds, u & 7, (u >> 3) & 15, u >> 7); }
}

struct Args { const float* in[20]; float* out; unsigned char* ws; int ph_lo, ph_hi; };
constexpr int NPH_PAIR = 21, NPH = 2 * NPH_PAIR;
constexpr int PT_OFF = LDS_BYTES - 512;
DI unsigned long long uni64(unsigned long long v) { const unsigned lo = __builtin_amdgcn_readfirstlane((unsigned)v), hi = __builtin_amdgcn_readfirstlane((unsigned)(v >> 32)); return ((unsigned long long)hi << 32) | lo; }
DI Ptrs load_ptrs(LAS unsigned char* lds) {
    Ptrs P; const LAS unsigned long long* t = (const LAS unsigned long long*)(lds + PT_OFF);
#pragma unroll
    for (int i = 0; i < 20; ++i) P.in[i] = (const float*)(const __attribute__((address_space(1))) float*)uni64(t[i]);
    P.out = (float*)(__attribute__((address_space(1))) float*)uni64(t[20]); P.ws = (unsigned char*)(__attribute__((address_space(1))) unsigned char*)uni64(t[21]);

    int tid_ = threadIdx.x; asm volatile("" : "+v"(tid_)); P.tid = tid_; P.lane = P.tid & 63; P.wave = __builtin_amdgcn_readfirstlane(P.tid >> 6); P.bid = blockIdx.x; P.G = gridDim.x;
    return P;
}
DI void grid_bar(LAS unsigned char* lds) {
    const Ptrs P = load_ptrs(lds);
    XcdBarrier bar; bar.bar = (unsigned*)(P.ws + WS_CTL) + CW_BAR; bar.x = xb_xcc_id(); bar.st = (volatile LAS unsigned*)(lds + LDS_BYTES - 16);
    xcd_barrier(bar);
}
__global__ void __launch_bounds__(NTHR, 2) fwd(Args args) {
    extern __shared__ __attribute__((aligned(16))) unsigned char lds_raw[];
    LAS unsigned char* lds = (LAS unsigned char*)lds_raw;
    const int lo = args.ph_lo, hi = args.ph_hi;
    {   LAS unsigned long long* t = (LAS unsigned long long*)(lds + PT_OFF);
        if (threadIdx.x == 0) {
#pragma unroll
            for (int i = 0; i < 20; ++i) t[i] = (unsigned long long)args.in[i];
            t[20] = (unsigned long long)args.out; t[21] = (unsigned long long)args.ws; }
        volatile LAS unsigned* bst = (volatile LAS unsigned*)(lds + LDS_BYTES - 16);
        if (threadIdx.x == 0) { bst[0] = 0u; bst[1] = 0u; }
        __syncthreads();
        if (hi - lo > 1) (void)xcd_barrier_post((unsigned*)(args.ws + WS_CTL) + CW_BAR, bst);
    }
#define PTRS() const Ptrs P = load_ptrs(lds); bf16* WIN = (bf16*)(P.ws + WS_WIN); bf16* WOUT = (bf16*)(P.ws + WS_WOUT); bf16* WUP = (bf16*)(P.ws + WS_WUP); bf16* WDN = (bf16*)(P.ws + WS_WDN); \
    float* XF = (float*)(P.ws + WS_XF); bf16* XB = (bf16*)(P.ws + WS_XB); bf16* PROJ = (bf16*)(P.ws + WS_R1); bf16* OB = (bf16*)(P.ws + WS_O); bf16* HB = (bf16*)(P.ws + WS_R1); \
    float* MIX = (float*)(P.ws + WS_MIX); bf16* XBUF = (bf16*)(P.ws + WS_XBUF); const int* pblk = (const int*)(P.ws + WS_MISC + MS_PBLK); \
    (void)WIN; (void)WOUT; (void)WUP; (void)WDN; (void)XF; (void)XB; (void)PROJ; (void)OB; (void)HB; (void)MIX; (void)XBUF; (void)pblk;

    for (int pair = 0; pair < 2; ++pair) {
        const int base = pair * NPH_PAIR;
#ifndef PHMASK
#define PHMASK 0x1fffff
#endif
#define IN(k) (((PHMASK >> (k)) & 1) && lo <= base + (k) && base + (k) < hi)
#define SEAM(k) do { if (base + (k) + 1 < hi) grid_bar(lds); } while (0)
        if (IN(0)) { PTRS(); if (pair == 0) phase_init(P); phase_convert_even(P, lds, pair); SEAM(0); }
        if (IN(1)) { PTRS(); pg8::Gemm g{XB, WIN, NTOK, EV_NP, DM}; pg8::StaticOrder S; S.init(NTOK, EV_NP, P.G, P.bid); pg8::EpiStoreBf16 E{PROJ, EV_NP};
            pg8::gemm_phase<pg8::EpiStoreBf16, pg8::StaticOrder, true, true>(lds, g, S, E); SEAM(1); }
        if (IN(2)) { PTRS(); phase_rope_even(P); SEAM(2); }
        if (IN(3)) { PTRS(); phase_index(P, lds); SEAM(3); }
        if (IN(4)) { PTRS(); phase_attn_even(P, lds); SEAM(4); }
        if (IN(5)) { PTRS(); pg8::Gemm g{OB, WOUT, NTOK, DM, DM}; pg8::StaticOrder S; S.init(NTOK, DM, P.G, P.bid); pg8::EpiF32 E{MIX, DM, pair == 0 ? P.in[0] : (const float*)XF, ALPHA};
            pg8::gemm_phase<pg8::EpiF32, pg8::StaticOrder, true, true>(lds, g, S, E); SEAM(5); }
        if (IN(6)) { PTRS(); phase_ln<false>(P, lds, P.in[3] + pair * DM, P.in[4] + pair * DM, XF, XB, nullptr); SEAM(6); }
        if (IN(7)) { PTRS(); pg8::Gemm g{XB, WUP, NTOK, 2 * FF, DM}; pg8::StaticOrder S; S.init(NTOK, 2 * FF, P.G, P.bid); pg8::EpiSwiGLU E{HB, FF};
            pg8::gemm_phase<pg8::EpiSwiGLU, pg8::StaticOrder, true, true>(lds, g, S, E); SEAM(7); }
        if (IN(8)) { PTRS(); pg8::Gemm g{HB, WDN, NTOK, DM, FF}; pg8::StaticOrder S; S.init(NTOK, DM, P.G, P.bid); pg8::EpiF32 E{MIX, DM, XF, ALPHA};
            pg8::gemm_phase<pg8::EpiF32, pg8::StaticOrder, true, true>(lds, g, S, E); SEAM(8); }
        if (IN(9)) { PTRS(); phase_ln<false>(P, lds, P.in[8] + pair * DM, P.in[9] + pair * DM, XF, XB, nullptr); SEAM(9); }
        if (IN(10)) { PTRS(); phase_convert_odd(P, lds, pair); SEAM(10); }
        if (IN(11)) { PTRS(); pg8::Gemm g{XB, WIN, NTOK, OD_N, DM}; pg8::StaticOrder S; S.init(NTOK, OD_N, P.G, P.bid); pg8::EpiStoreBf16 E{PROJ, OD_N};
            pg8::gemm_phase<pg8::EpiStoreBf16, pg8::StaticOrder, true, true>(lds, g, S, E); SEAM(11); }
        if (IN(12)) { PTRS(); phase_rope_odd(P); SEAM(12); }
        if (IN(13)) { PTRS(); phase_b3(P, lds); SEAM(13); }
        if (IN(14)) { PTRS(); phase_band(P, lds); SEAM(14); }
        if (IN(15)) { PTRS(); pg8::Gemm g{OB, WOUT, NTOK, DM, DM}; pg8::StaticOrder S; S.init(NTOK, DM, P.G, P.bid); pg8::EpiF32 E{MIX, DM, XF, ALPHA};
            pg8::gemm_phase<pg8::EpiF32, pg8::StaticOrder, true, true>(lds, g, S, E); SEAM(15); }
        if (IN(16)) { PTRS(); phase_ln<true>(P, lds, P.in[12] + pair * DM, P.in[13] + pair * DM, XF, XB, P.in[14] + (size_t)pair * DM * NEXP); SEAM(16); }
        if (IN(17)) { PTRS(); phase_route(P, lds); SEAM(17); }
        if (IN(18)) { PTRS(); pg8::Gemm g{XBUF, WUP, MOE_ROWS, 2 * FFE, DM}; pg8::MoeOrder S; S.init(pblk, 2 * FFE / 256, (long)2 * FFE * DM * 2, P.G, P.bid); pg8::EpiSwiGLU E{HB, FFE};
            pg8::gemm_phase<pg8::EpiSwiGLU, pg8::MoeOrder, true, true>(lds, g, S, E); SEAM(18); }
        if (IN(19)) { PTRS(); pg8::Gemm g{HB, WDN, MOE_ROWS, DM, FFE}; pg8::MoeOrder S; S.init(pblk, DM / 256, (long)DM * FFE * 2, P.G, P.bid); pg8::EpiF32 E{MIX, DM, nullptr, 0.f};
            pg8::gemm_phase<pg8::EpiF32, pg8::MoeOrder, true, true>(lds, g, S, E); SEAM(19); }
        if (IN(20)) { PTRS(); phase_moe_combine(P, P.in[18] + pair * DM, P.in[19] + pair * DM, pair == 1 ? P.out : XF, pair == 1 ? nullptr : XB); SEAM(20); }
#undef IN
#undef SEAM
    }
}

#ifdef DBG_STOP
__global__ void dbg_dump(float* out, const unsigned char* ws, const float* x, int src) {
    const size_t n = (size_t)NTOK * DM;
    for (size_t i = (size_t)blockIdx.x * blockDim.x + threadIdx.x; i < n; i += (size_t)gridDim.x * blockDim.x) {
        float v;
        switch (src) {
            case 0: v = x[i]; break;
            case 1: v = bf2f(((const bf16*)(ws + WS_XB))[i]); break;
            case 2: v = bf2f(((const bf16*)(ws + WS_R1))[i]); break;
            case 3: v = ((const float*)(ws + WS_MIX))[i]; break;
            case 4: v = ((const float*)(ws + WS_XF))[i]; break;
            case 5: v = bf2f(((const bf16*)(ws + WS_O))[i]); break;
            case 8: { const float o = bf2f(((const bf16*)(ws + WS_O))[i]); const bool bad = !(fabsf(o) < 1e30f); v = ((i & 1023) < 512) ? (bad ? 1000.f : 0.f) : 0.f; } break;
            case 10: { const float o = bf2f(((const bf16*)(ws + WS_O))[i]); const bool bad = !(fabsf(o) < 1e30f); const int t = (int)((i >> 10) & 2047); v = ((i & 1023) < 512 && bad) ? 32.f * (float)(1 << (t >> 8)) : 0.f; } break;
            case 11: { const float o = bf2f(((const bf16*)(ws + WS_O))[i]); const bool bad = !(fabsf(o) < 1e30f); const int b = (int)(i >> 21); v = ((i & 1023) < 512 && bad) ? 32.f * (float)(1 << b) : 0.f; } break;
            case 12: { const float o = bf2f(((const bf16*)(ws + WS_O))[i]); const bool bad = !(fabsf(o) < 1e30f); const int t = (int)((i >> 10) & 2047); v = ((i & 1023) < 512 && bad) ? 32.f * (float)(1 << ((t >> 5) & 7)) : 0.f; } break;
            case 13: { const float o = bf2f(((const bf16*)(ws + WS_O))[i]); const bool bad = !(fabsf(o) < 1e30f); const int hh = (int)((i >> 6) & 7); v = ((i & 1023) < 512 && bad) ? 32.f * (float)(1 << hh) : 0.f; } break;
            case 14: { v = 0.f; if ((i & 1023) == 0) { const int row = (int)(i >> 10); int cnt = 0; for (int w = 0; w < 64; ++w) cnt += __popc(((const unsigned*)(ws + WS_MASK))[row * 64 + w]); const int t = row & 2047; const int ex = t + 1 < 256 ? t + 1 : 256; v = (cnt != ex) ? 1000.f : 0.f; } } break;
            case 15: { const float o = bf2f(((const bf16*)(ws + WS_O))[i]); v = ((i & 1023) < 512) ? o : 0.f; } break;
            case 9: { const float o = bf2f(((const bf16*)(ws + WS_O))[i]); const bool bad = !(fabsf(o) < 1e30f); v = ((i & 1023) >= 512) ? (bad ? 1000.f : 0.f) : 0.f; } break;
            case 6: v = (float)(((const unsigned*)(ws + WS_MASK))[i & (NTOK * 64 - 1)] & 0xffffu); break;
            case 7: v = bf2f(((const bf16*)(ws + WS_WUP))[i]); break;
            default: v = 0.f;
        }
        out[i] = v;
    }
}
#endif
#ifndef MK_SPLIT
#define MK_SPLIT 1
#endif
extern "C" void kernel_launch(void* const* d_in, const int* in_sizes, int n_in, void* d_out, int out_size, void* d_ws, size_t ws_size, hipStream_t stream) {
    static int grid = 0;
    if (grid == 0) {
        if (n_in != 20 || in_sizes[0] != NTOK * DM || out_size != NTOK * DM || ws_size < WS_END) { fprintf(stderr, "kernel_launch: unexpected problem (n_in %d, in0 %d, out %d, ws %zu); nothing launched\n", n_in, n_in > 0 ? in_sizes[0] : -1, out_size, ws_size); grid = -1; return; }
        int dev = 0, cus = 0, per_cu = 0;
        if (hipGetDevice(&dev) != hipSuccess || hipDeviceGetAttribute(&cus, hipDeviceAttributeMultiprocessorCount, dev) != hipSuccess) { grid = -1; return; }
        if (hipFuncSetAttribute((const void*)fwd, hipFuncAttributeMaxDynamicSharedMemorySize, LDS_BYTES) != hipSuccess) { fprintf(stderr, "kernel_launch: hipFuncSetAttribute failed\n"); grid = -1; return; }
        if (hipOccupancyMaxActiveBlocksPerMultiprocessor(&per_cu, (const void*)fwd, NTHR, LDS_BYTES) != hipSuccess || per_cu < 1) fprintf(stderr, "kernel_launch: note: occupancy query reports %d\n", per_cu);
        (void)hipGetLastError();
        grid = cus;
    }
    if (grid < 0) return;
    if (hipMemsetAsync((char*)d_ws + WS_CTL, 0, CTL_ZERO_BYTES, stream) != hipSuccess) return;
    Args a{};
    for (int i = 0; i < 20; ++i) a.in[i] = (const float*)d_in[i];
    a.out = (float*)d_out; a.ws = (unsigned char*)d_ws;
#ifdef DBG_STOP
    for (int p = 0; p < DBG_STOP; ++p) { a.ph_lo = p; a.ph_hi = p + 1; hipLaunchKernelGGL(fwd, dim3(grid), dim3(NTHR), LDS_BYTES, stream, a); }
    hipLaunchKernelGGL(dbg_dump, dim3(1024), dim3(256), 0, stream, (float*)d_out, (const unsigned char*)d_ws, (const float*)d_in[0], (int)DBG_SRC);
#elif MK_SPLIT
#ifndef REP_MASK
#define REP_MASK 0
#endif
    for (int p = 0; p < NPH; ++p) { a.ph_lo = p; a.ph_hi = p + 1; const int reps = ((REP_MASK >> (p % NPH_PAIR)) & 1) ? 2 : 1;
        for (int r = 0; r < reps; ++r) hipLaunchKernelGGL(fwd, dim3(grid), dim3(NTHR), LDS_BYTES, stream, a); }
#else
    a.ph_lo = 0; a.ph_hi = NPH; hipLaunchKernelGGL(fwd, dim3(grid), dim3(NTHR), LDS_BYTES, stream, a);
#endif
}
```
